# Optimizing an MI355X kernel written in HIP

```python
import jax, jax.numpy as jnp
from jax import lax
import numpy as np

D_MODEL = 1024
BATCH = 16
SEQ = 4096
DEPTH = 4

CTX_LEN = 256
GRID_W = 64
EPS = 1e-6
NEG_INF = -1e30

HEAD_DIM = 64
ATTN_HEADS = D_MODEL // 128
ATTN_KV_HEADS = ATTN_HEADS // 4
ATTN_GROUP = ATTN_HEADS // ATTN_KV_HEADS
ATTN_WIDTH = ATTN_HEADS * HEAD_DIM
KV_WIDTH = ATTN_KV_HEADS * HEAD_DIM
WINDOW = 128
BLOCK = 128
ROPE_BASE = 10000.0
ROPE_FREQS = HEAD_DIM // 4

SSM_WIDTH = D_MODEL // 2
SSM_GROUP = 16
SSM_GROUPS = SSM_WIDTH // SSM_GROUP
SSM_STATE = 64
DT_MIN = 1e-3
DT_MAX = 1e-1

EVEN_IN = 2 * ATTN_WIDTH + 2 * KV_WIDTH + 2 * SSM_WIDTH
EVEN_MIX = ATTN_WIDTH + SSM_WIDTH

POOL_WIDTH = D_MODEL
POOL_WINDOWS = (2, 4, 8, 16)
POOL_GROUP = POOL_WIDTH // len(POOL_WINDOWS)

kernel_name = 'hybrid_swa_s5_pool_prefix_dit'


def rmsnorm(x, g):
    xf = x.astype(jnp.float32)
    y = xf * lax.rsqrt(jnp.mean(xf * xf, axis=-1, keepdims=True) + EPS)
    return (y * g.astype(jnp.float32)).astype(x.dtype)


def axial_rope_tables(n_tokens):
    rows = n_tokens // GRID_W
    row = jnp.repeat(jnp.arange(rows, dtype=jnp.float32), GRID_W)
    col = jnp.tile(jnp.arange(GRID_W, dtype=jnp.float32), rows)
    inv_freq = ROPE_BASE ** (-jnp.arange(ROPE_FREQS, dtype=jnp.float32) / ROPE_FREQS)
    ang = jnp.stack([row[:, None] * inv_freq, col[:, None] * inv_freq], axis=1)
    ang = ang[:, None]
    return jnp.cos(ang), jnp.sin(ang)


def apply_axial_rope(x, cos, sin):
    b, l, h, _ = x.shape
    xr = x.astype(jnp.float32).reshape(b, l, h, 2, 2, ROPE_FREQS)
    x1, x2 = xr[..., 0, :], xr[..., 1, :]
    out = jnp.stack([x1 * cos - x2 * sin, x2 * cos + x1 * sin], axis=-2)
    return out.reshape(b, l, h, HEAD_DIM).astype(x.dtype)


def window_attention(q, k, v, kc, vc, sink):
    b, l, hkv, g, dh = q.shape
    nb = l // BLOCK
    scale = dh ** -0.5
    qb = q.reshape(b, nb, BLOCK, hkv, g, dh)
    pad = ((0, 0), (BLOCK, BLOCK), (0, 0), (0, 0))
    kp = jnp.pad(k, pad).reshape(b, nb + 2, BLOCK, hkv, dh)
    vp = jnp.pad(v, pad).reshape(b, nb + 2, BLOCK, hkv, dh)
    kb = jnp.concatenate([kp[:, :-2], kp[:, 1:-1], kp[:, 2:]], axis=2)
    vb = jnp.concatenate([vp[:, :-2], vp[:, 1:-1], vp[:, 2:]], axis=2)
    s_loc = jnp.einsum('bnqhgd,bnkhd->bnhgqk', qb, kb).astype(jnp.float32) * scale
    s_ctx = jnp.einsum('bnqhgd,bkhd->bnhgqk', qb, kc).astype(jnp.float32) * scale
    qpos = np.arange(nb)[:, None] * BLOCK + np.arange(BLOCK)[None, :]
    kpos = (np.arange(nb)[:, None] - 1) * BLOCK + np.arange(3 * BLOCK)[None, :]
    valid = ((np.abs(qpos[:, :, None] - kpos[:, None, :]) <= WINDOW)
             & (kpos[:, None, :] >= 0) & (kpos[:, None, :] < l))
    s_loc = jnp.where(valid[None, :, None, None], s_loc, NEG_INF)
    s_sink = jnp.broadcast_to(sink.astype(jnp.float32)[None, None, :, :, None, None],
                              s_loc.shape[:-1] + (1,))
    p = jax.nn.softmax(jnp.concatenate([s_loc, s_ctx, s_sink], axis=-1), axis=-1)
    n_loc = 3 * BLOCK
    n_ctx = kc.shape[1]
    p_loc = p[..., :n_loc].astype(v.dtype)
    p_ctx = p[..., n_loc:n_loc + n_ctx].astype(v.dtype)
    out = (jnp.einsum('bnhgqk,bnkhd->bnqhgd', p_loc, vb)
           + jnp.einsum('bnhgqk,bkhd->bnqhgd', p_ctx, vc))
    return out.reshape(b, l, hkv * g * dh)


def context_attention(qc, kc, vc, sink):
    b, lc, hkv, g, dh = qc.shape
    s = jnp.einsum('bqhgd,bkhd->bhgqk', qc, kc).astype(jnp.float32) * dh ** -0.5
    s_sink = jnp.broadcast_to(sink.astype(jnp.float32)[None, :, :, None, None], s.shape[:-1] + (1,))
    p = jax.nn.softmax(jnp.concatenate([s, s_sink], axis=-1), axis=-1)[..., :lc].astype(vc.dtype)
    return jnp.einsum('bhgqk,bkhd->bqhgd', p, vc).reshape(b, lc, hkv * g * dh)


def s5_discretize(a_re, a_im, log_dt, b_re, b_im):
    lam = lax.complex(a_re.astype(jnp.float32), a_im.astype(jnp.float32))
    dt = jnp.exp(log_dt.astype(jnp.float32))[:, None]
    a_bar = jnp.exp(lam * dt)
    bmat = lax.complex(b_re.astype(jnp.float32), b_im.astype(jnp.float32))
    b_bar = ((a_bar - 1.0) / lam)[..., None] * bmat
    return a_bar, b_bar


def _scan_combine(left, right):
    a_l, h_l = left
    a_r, h_r = right
    return a_l * a_r, a_r * h_l + h_r


def diag_scan(a_bar, bu, h0):
    if h0 is not None:
        bu = bu.at[:, 0].add(a_bar * h0)
    a = jnp.broadcast_to(a_bar, bu.shape)
    _, h = lax.associative_scan(_scan_combine, (a, bu), axis=1)
    return h


def s5_branch(u, uc, a_re, a_im, log_dt, b_re, b_im, c_re, c_im, d_skip, glu_w, glu_b, need_ctx):
    b, l, _ = u.shape
    lc = uc.shape[1]
    ul = u.astype(jnp.float32).reshape(b, l, SSM_GROUPS, SSM_GROUP).astype(jnp.complex64)
    ucg = uc.astype(jnp.float32).reshape(b, lc, SSM_GROUPS, SSM_GROUP).astype(jnp.complex64)
    d = d_skip.astype(jnp.float32)
    y = u.astype(jnp.float32) * d
    yc = uc.astype(jnp.float32) * d if need_ctx else None
    for direction in range(2):
        a_bar, b_bar = s5_discretize(a_re[direction], a_im[direction], log_dt[direction],
                                     b_re[direction], b_im[direction])
        cmat = lax.complex(c_re[direction].astype(jnp.float32), c_im[direction].astype(jnp.float32))
        bu = jnp.einsum('blgc,gpc->blgp', ul, b_bar)
        buc = jnp.einsum('blgc,gpc->blgp', ucg, b_bar)
        if direction == 1:
            bu, buc = bu[:, ::-1], buc[:, ::-1]
        hc = diag_scan(a_bar, buc, None)
        h = diag_scan(a_bar, bu, hc[:, -1])
        if direction == 1:
            h, hc = h[:, ::-1], hc[:, ::-1]
        y = y + jnp.real(jnp.einsum('blgp,gcp->blgc', h, cmat)).reshape(b, l, SSM_WIDTH)
        if need_ctx:
            yc = yc + jnp.real(jnp.einsum('blgp,gcp->blgc', hc, cmat)).reshape(b, lc, SSM_WIDTH)
    gw = glu_w.astype(jnp.float32)
    gb = glu_b.astype(jnp.float32)

    def glu(z):
        z = jax.nn.gelu(z)
        return z * jax.nn.sigmoid(z @ gw + gb)

    out = glu(y).astype(u.dtype)
    out_c = glu(yc).astype(u.dtype) if need_ctx else None
    return out, out_c


def attn_ssm_mixer(a, ac, cos, sin, w_in, w_out, sink, a_re, a_im, log_dt, b_re, b_im,
                   c_re, c_im, d_skip, glu_w, glu_b, need_ctx):
    b, l, _ = a.shape
    lc = ac.shape[1]
    cuts = [int(v) for v in np.cumsum([ATTN_WIDTH, KV_WIDTH, KV_WIDTH, ATTN_WIDTH, SSM_WIDTH])]
    q, k, v, g_attn, u, g_ssm = jnp.split(a @ w_in, cuts, axis=-1)
    qc, kc, vc, g_attn_c, uc, g_ssm_c = jnp.split(ac @ w_in, cuts, axis=-1)
    q = apply_axial_rope(q.reshape(b, l, ATTN_HEADS, HEAD_DIM), cos, sin)
    q = q.reshape(b, l, ATTN_KV_HEADS, ATTN_GROUP, HEAD_DIM)
    k = apply_axial_rope(k.reshape(b, l, ATTN_KV_HEADS, HEAD_DIM), cos, sin)
    v = v.reshape(b, l, ATTN_KV_HEADS, HEAD_DIM)
    kc = kc.reshape(b, lc, ATTN_KV_HEADS, HEAD_DIM)
    vc = vc.reshape(b, lc, ATTN_KV_HEADS, HEAD_DIM)
    sink = sink.reshape(ATTN_KV_HEADS, ATTN_GROUP)
    o_attn = window_attention(q, k, v, kc, vc, sink) * jax.nn.silu(g_attn)
    o_ssm, o_ssm_c = s5_branch(u, uc, a_re, a_im, log_dt, b_re, b_im, c_re, c_im,
                               d_skip, glu_w, glu_b, need_ctx)
    y = jnp.concatenate([o_attn, o_ssm * jax.nn.silu(g_ssm)], axis=-1) @ w_out
    yc = None
    if need_ctx:
        qc = qc.reshape(b, lc, ATTN_KV_HEADS, ATTN_GROUP, HEAD_DIM)
        o_attn_c = context_attention(qc, kc, vc, sink) * jax.nn.silu(g_attn_c)
        yc = jnp.concatenate([o_attn_c, o_ssm_c * jax.nn.silu(g_ssm_c)], axis=-1) @ w_out
    return y, yc


def multiscale_pool(u):
    t_len = u.shape[1]
    uf = u.astype(jnp.float32)
    cs = jnp.pad(jnp.cumsum(uf, axis=1), ((0, 0), (1, 0), (0, 0)))
    pos = np.arange(t_len)
    outs = []
    for gi, w in enumerate(POOL_WINDOWS):
        r = w // 2
        lo = np.clip(pos - r, 0, t_len)
        hi = np.clip(pos + r + 1, 0, t_len)
        inv_cnt = jnp.asarray(1.0 / (hi - lo), dtype=jnp.float32)[None, :, None]
        sl = slice(gi * POOL_GROUP, (gi + 1) * POOL_GROUP)
        csg = cs[..., sl]
        outs.append((csg[:, hi] - csg[:, lo]) * inv_cnt - uf[..., sl])
    return jnp.concatenate(outs, axis=-1)


def pool_mixer(a, w_in, w_out, pool_w, pool_scale):
    u, gate = jnp.split(a @ w_in, 2, axis=-1)
    b, t, _ = u.shape
    p = multiscale_pool(u).reshape(b, t, len(POOL_WINDOWS), POOL_GROUP)
    p = jnp.einsum('btgc,gcd->btgd', p, pool_w.astype(jnp.float32)).reshape(b, t, POOL_WIDTH)
    p = (p * pool_scale.astype(jnp.float32)).astype(a.dtype)
    return (p * jax.nn.silu(gate)) @ w_out


def setup_inputs(seed: int = 0) -> dict:
    key = jax.random.key(seed)
    ks = iter(jax.random.split(key, 32))
    n_even = (DEPTH + 1) // 2
    n_odd = DEPTH // 2

    def nrm(shape, scale):
        return jax.random.normal(next(ks), shape, jnp.float32) * scale

    n_idx = jnp.arange(SSM_STATE, dtype=jnp.float32)
    ssm_shape = (n_even, 2, SSM_GROUPS, SSM_STATE)
    return {
        'x': nrm((BATCH, SEQ, D_MODEL), 1.0),
        'c': nrm((BATCH, D_MODEL), 1.0),
        'ctx': nrm((BATCH, CTX_LEN, D_MODEL), 1.0),
        'c_ctx': nrm((D_MODEL,), 1.0),
        'ada_w': nrm((DEPTH, D_MODEL, 3 * D_MODEL), 0.5 * D_MODEL ** -0.5),
        'ada_b': nrm((DEPTH, 3 * D_MODEL), 0.01),
        'norm_g': 1.0 + nrm((DEPTH, D_MODEL), 0.02),
        'even_w_in': nrm((n_even, D_MODEL, EVEN_IN), D_MODEL ** -0.5),
        'even_w_out': nrm((n_even, EVEN_MIX, D_MODEL), EVEN_MIX ** -0.5),
        'attn_sink': nrm((n_even, ATTN_HEADS), 0.5),
        'ssm_a_re': -0.5 + nrm(ssm_shape, 0.01),
        'ssm_a_im': jnp.pi * n_idx + nrm(ssm_shape, 0.01),
        'ssm_log_dt': jax.random.uniform(next(ks), (n_even, 2, SSM_GROUPS), jnp.float32,
                                         np.log(DT_MIN), np.log(DT_MAX)),
        'ssm_b_re': nrm((n_even, 2, SSM_GROUPS, SSM_STATE, SSM_GROUP), (2 * SSM_GROUP) ** -0.5),
        'ssm_b_im': nrm((n_even, 2, SSM_GROUPS, SSM_STATE, SSM_GROUP), (2 * SSM_GROUP) ** -0.5),
        'ssm_c_re': nrm((n_even, 2, SSM_GROUPS, SSM_GROUP, SSM_STATE), (2 * SSM_STATE) ** -0.5),
        'ssm_c_im': nrm((n_even, 2, SSM_GROUPS, SSM_GROUP, SSM_STATE), (2 * SSM_STATE) ** -0.5),
        'ssm_d': nrm((n_even, SSM_WIDTH), 0.5),
        'glu_w': nrm((n_even, SSM_WIDTH, SSM_WIDTH), SSM_WIDTH ** -0.5),
        'glu_b': nrm((n_even, SSM_WIDTH), 0.01),
        'odd_w_in': nrm((n_odd, D_MODEL, 2 * POOL_WIDTH), D_MODEL ** -0.5),
        'odd_w_out': nrm((n_odd, POOL_WIDTH, D_MODEL), POOL_WIDTH ** -0.5),
        'pool_w': nrm((n_odd, len(POOL_WINDOWS), POOL_GROUP, POOL_GROUP), POOL_GROUP ** -0.5),
        'pool_scale': 1.0 + nrm((n_odd, POOL_WIDTH), 0.02),
        'final_g': 1.0 + nrm((D_MODEL,), 0.02),
    }


def reference(x, c, ctx, c_ctx, ada_w, ada_b, norm_g, even_w_in, even_w_out, attn_sink,
              ssm_a_re, ssm_a_im, ssm_log_dt, ssm_b_re, ssm_b_im, ssm_c_re, ssm_c_im, ssm_d,
              glu_w, glu_b, odd_w_in, odd_w_out, pool_w, pool_scale, final_g):
    cos, sin = axial_rope_tables(x.shape[1])
    h, hc = x, ctx
    s_lat = jax.nn.silu(c)
    s_ctx = jax.nn.silu(c_ctx)
    for i in range(DEPTH):
        need_ctx = i < DEPTH - 1
        shift, scale, gate = jnp.split((s_lat @ ada_w[i] + ada_b[i])[:, None, :], 3, axis=-1)
        shift_c, scale_c, gate_c = jnp.split(s_ctx @ ada_w[i] + ada_b[i], 3, axis=-1)
        a = rmsnorm(h, norm_g[i]) * (1.0 + scale) + shift
        ac = rmsnorm(hc, norm_g[i]) * (1.0 + scale_c) + shift_c
        j = i // 2
        if i % 2 == 0:
            y, yc = attn_ssm_mixer(a, ac, cos, sin, even_w_in[j], even_w_out[j], attn_sink[j],
                                   ssm_a_re[j], ssm_a_im[j], ssm_log_dt[j], ssm_b_re[j], ssm_b_im[j],
                                   ssm_c_re[j], ssm_c_im[j], ssm_d[j], glu_w[j], glu_b[j], need_ctx)
        else:
            y = pool_mixer(a, odd_w_in[j], odd_w_out[j], pool_w[j], pool_scale[j])
            yc = pool_mixer(ac, odd_w_in[j], odd_w_out[j], pool_w[j], pool_scale[j]) if need_ctx else None
        h = h + gate * y
        if need_ctx:
            hc = hc + gate_c * yc
    return rmsnorm(h, final_g)
```

```cpp
#ifndef DUP_PHASE
#define DUP_PHASE (-1)
#endif
#include <hip/hip_runtime.h>
#include <hip/hip_cooperative_groups.h>
#include <cstdio>
#include <cstdint>
namespace cg = cooperative_groups;

typedef unsigned short bf16_t;
typedef short bf16x8 __attribute__((ext_vector_type(8)));
typedef float f32x4 __attribute__((ext_vector_type(4)));
typedef unsigned u32x4 __attribute__((ext_vector_type(4)));

#define NLAT 65536
#define MALL 69632
#define DM 1024
#define LDO 2304
#define LDP 2304
#define LDS_BYTES 147456
#define NTHREADS 512
#define NWAVES 8

struct P {
  const float *x, *c, *ctx, *c_ctx, *ada_w, *ada_b, *norm_g, *even_w_in, *even_w_out, *attn_sink,
      *a_re, *a_im, *log_dt, *b_re, *b_im, *c_re, *c_im, *ssm_d, *glu_w, *glu_b, *odd_w_in, *odd_w_out,
      *pool_w, *pool_scale, *final_g;
  float* out;
  float *mod, *rope, *hctx, *aT, *klag, *Sbuf, *rowss, *bias;
  bf16_t *WinE, *WoutE, *Wglu, *WinO, *WoutO, *Wpool, *Wst, *W2, *abuf, *bbuf, *proj, *XH, *WuO;
  unsigned* bar;
  int ph_lo, ph_hi;
};

__device__ __forceinline__ bf16_t f2bf(float f) {
  unsigned u = __float_as_uint(f);
  u += 0x7fffu + ((u >> 16) & 1u);
  return (bf16_t)(u >> 16);
}
__device__ __forceinline__ int lane_id_opaque() { int l; asm volatile("v_mbcnt_lo_u32_b32 %0, -1, 0\n\tv_mbcnt_hi_u32_b32 %0, -1, %0" : "=v"(l)); return l; }
__device__ __forceinline__ float shflx(float v, int mask, int lane) { return __int_as_float(__builtin_amdgcn_ds_bpermute((lane ^ mask) << 2, __float_as_int(v))); }
__device__ __forceinline__ float bf2f(bf16_t h) { return __uint_as_float(((unsigned)h) << 16); }
typedef __bf16 bf16x2_t __attribute__((ext_vector_type(2)));
typedef float f32x2_t __attribute__((ext_vector_type(2)));
__device__ __forceinline__ unsigned pack2(float a, float b) {
  f32x2_t v = {a, b};
  bf16x2_t r = __builtin_convertvector(v, bf16x2_t);
  return __builtin_bit_cast(unsigned, r);
}
__device__ __forceinline__ float sigmoidf_(float x) { return __builtin_amdgcn_rcpf(1.0f + __builtin_amdgcn_exp2f(-1.4426950408889634f * x)); }
__device__ __forceinline__ float siluf_(float x) { return x * sigmoidf_(x); }
__device__ __forceinline__ float geluf_(float x) {
  float u = 0.7978845608028654f * (x + 0.044715f * x * x * x);
  return x * sigmoidf_(2.0f * u);
}
__device__ __forceinline__ const float* hin_row(const P& p, int layer, int row) {
  if (layer == 0) return row < NLAT ? p.x + (size_t)row * DM : p.ctx + (size_t)(row - NLAT) * DM;
  return row < NLAT ? p.out + (size_t)row * DM : p.hctx + (size_t)(row - NLAT) * DM;
}
__device__ __forceinline__ float* hout_row(const P& p, int row) {
  return row < NLAT ? p.out + (size_t)row * DM : p.hctx + (size_t)(row - NLAT) * DM;
}

__device__ __forceinline__ void setup_mod_item(const P& p, char* smem, int item, const int wv_) {
  const int layer = item / 48, cgp = item % 48;
  float* s = (float*)smem;
  int tid = (wv_ * 64 + lane_id_opaque()); asm volatile("" : "+v"(tid));
  const int lane = tid & 63, w = tid >> 6;
  for (int idx = tid; idx < 17 * 1024; idx += NTHREADS) {
    int b = idx >> 10, k = idx & 1023;
    float v = (b < 16) ? p.c[b * 1024 + k] : p.c_ctx[k];
    s[idx] = siluf_(v);
  }
  __syncthreads();
  float acc[17];
#pragma unroll
  for (int b = 0; b < 17; ++b) acc[b] = 0.f;
  const int n = cgp * 64 + lane;
  const float* wp = p.ada_w + ((size_t)layer * 1024 + w * 128) * 3072 + n;
  const float* sp = s + w * 128;
#pragma unroll 4
  for (int k = 0; k < 128; ++k) {
    float wv = wp[(size_t)k * 3072];
#pragma unroll
    for (int b = 0; b < 17; ++b) acc[b] += sp[b * 1024 + k] * wv;
  }
  __syncthreads();
  float* red = (float*)smem;
#pragma unroll
  for (int b = 0; b < 17; ++b) red[(w * 17 + b) * 64 + lane] = acc[b];
  __syncthreads();
  for (int idx = tid; idx < 17 * 64; idx += NTHREADS) {
    int b = idx >> 6, ln = idx & 63;
    float v = 0.f;
#pragma unroll
    for (int ww = 0; ww < NWAVES; ++ww) v += red[(ww * 17 + b) * 64 + ln];
    int nn = cgp * 64 + ln;
    p.mod[((size_t)layer * 17 + b) * 3072 + nn] = v + p.ada_b[layer * 3072 + nn];
  }
  __syncthreads();
}

__device__ __forceinline__ void transpose_tile(char* smem, const float* src, bf16_t* dst, int K, int N, int tile, const int wv_) {
  float* t = (float*)smem;
  const int tilesN = N / 64;
  const int k0 = (tile / tilesN) * 64, n0 = (tile % tilesN) * 64;
  int tid = (wv_ * 64 + lane_id_opaque()); asm volatile("" : "+v"(tid));
  const int tk = tid >> 6, tn = tid & 63;
#pragma unroll
  for (int r = 0; r < 8; ++r) {
    int k = r * 8 + tk;
    t[k * 65 + tn] = src[(size_t)(k0 + k) * N + n0 + tn];
  }
  __syncthreads();
#pragma unroll
  for (int r = 0; r < 8; ++r) {
    int n = r * 8 + tk;
    dst[(size_t)(n0 + n) * K + k0 + tn] = f2bf(t[tn * 65 + n]);
  }
  __syncthreads();
}

__device__ __forceinline__ float2 cmul(float2 a, float2 b) { return make_float2(a.x * b.x - a.y * b.y, a.x * b.y + a.y * b.x); }

__device__ __forceinline__ void setup_s5_item(const P& p, char* smem, int item, const int wv_) {
  const int j = item >> 5, g = item & 31;
  int tid = (wv_ * 64 + lane_id_opaque()); asm volatile("" : "+v"(tid));
  float2* pw = (float2*)smem;
  float2* Bb = pw + 2 * 17 * 64;
  float2* Cc = Bb + 2 * 64 * 16;
  float* klag = p.klag + (size_t)item * 8192;
  for (int idx = tid; idx < 2 * 17 * 64; idx += NTHREADS) {
    int dir = idx / (17 * 64), r = idx % (17 * 64), n = r >> 6, pp = r & 63;
    int pi = ((j * 2 + dir) * 32 + g) * 64 + pp;
    float dt = expf(p.log_dt[(j * 2 + dir) * 32 + g]);
    float xr = p.a_re[pi] * dt * (float)n, xi = p.a_im[pi] * dt * (float)n;
    float e = expf(xr), sn, cs;
    sincosf(xi, &sn, &cs);
    pw[idx] = make_float2(e * cs, e * sn);
  }
  for (int idx = tid; idx < 2 * 64 * 16; idx += NTHREADS) {
    int dir = idx >> 10, r = idx & 1023, pp = r >> 4, cc = r & 15;
    int pi = ((j * 2 + dir) * 32 + g) * 64 + pp;
    float dt = expf(p.log_dt[(j * 2 + dir) * 32 + g]);
    float lr = p.a_re[pi], li = p.a_im[pi];
    float xr = lr * dt, xi = li * dt;
    float sn, cs, sh, ch;
    sincosf(xi, &sn, &cs);
    sincosf(0.5f * xi, &sh, &ch);
    float em1 = expm1f(xr);
    float nr = em1 * cs - 2.0f * sh * sh, ni = (em1 + 1.0f) * sn;
    float den = lr * lr + li * li;
    float2 coef = make_float2((nr * lr + ni * li) / den, (ni * lr - nr * li) / den);
    size_t bi = (size_t)pi * 16 + cc;
    Bb[idx] = cmul(coef, make_float2(p.b_re[bi], p.b_im[bi]));
  }
  for (int idx = tid; idx < 2 * 16 * 64; idx += NTHREADS) {
    int dir = idx >> 10, r = idx & 1023, cc = r >> 6, pp = r & 63;
    size_t ci = ((size_t)((j * 2 + dir) * 32 + g) * 16 + cc) * 64 + pp;
    Cc[idx] = make_float2(p.c_re[ci], p.c_im[ci]);
  }
  __syncthreads();
  for (int idx = tid; idx < 8192; idx += NTHREADS) {
    int dir = idx >> 12, d = (idx >> 8) & 15, co = (idx >> 4) & 15, ci = idx & 15;
    float acc = 0.f;
    for (int pp = 0; pp < 64; ++pp) {
      float2 q = cmul(Cc[(dir * 16 + co) * 64 + pp], pw[(dir * 17 + d) * 64 + pp]);
      float2 bb = Bb[(dir * 64 + pp) * 16 + ci];
      acc += q.x * bb.x - q.y * bb.y;
    }
    klag[idx] = acc;
  }
  bf16_t* Wst = p.Wst + (size_t)item * 65536;
  for (int idx = tid; idx < 65536; idx += NTHREADS) {
    int n = idx >> 8, k = idx & 255;
    int dir = n >> 7, ri = (n >> 6) & 1, pp = n & 63, sg = k >> 4, cc = k & 15;
    int e = dir == 0 ? 15 - sg : sg;
    float2 v = cmul(pw[(dir * 17 + e) * 64 + pp], Bb[(dir * 64 + pp) * 16 + cc]);
    Wst[idx] = f2bf(ri == 0 ? v.x : v.y);
  }
  if (tid < 128) {
    int dir = tid >> 6, pp = tid & 63;
    float2 v = pw[(dir * 17 + 16) * 64 + pp];
    p.aT[((size_t)item * 2 + dir) * 128 + pp * 2] = v.x;
    p.aT[((size_t)item * 2 + dir) * 128 + pp * 2 + 1] = v.y;
  }
  __syncthreads();
  bf16_t* W2 = p.W2 + (size_t)item * 131072;
  for (int idx = tid; idx < 131072; idx += NTHREADS) {
    int n = idx >> 9, k = idx & 511;
    int tau = n >> 4, co = n & 15;
    float val;
    if (k < 256) {
      int sg = k >> 4, ci = k & 15;
      if (sg < tau) val = klag[((0 * 16 + (tau - sg)) * 16 + co) * 16 + ci];
      else if (sg > tau) val = klag[((1 * 16 + (sg - tau)) * 16 + co) * 16 + ci];
      else val = klag[((0 * 16 + 0) * 16 + co) * 16 + ci] + klag[((1 * 16 + 0) * 16 + co) * 16 + ci];
    } else {
      int kk = k - 256, dir = kk >> 7, ri = (kk >> 6) & 1, pp = kk & 63;
      int e = dir == 0 ? tau + 1 : 16 - tau;
      float2 q = cmul(Cc[(dir * 16 + co) * 64 + pp], pw[(dir * 17 + e) * 64 + pp]);
      val = ri == 0 ? q.x : -q.y;
    }
    W2[idx] = f2bf(val);
  }
  __syncthreads();
}

#define N_MOD_ITEMS 192
#define N_S5_ITEMS 64
#define T_WINE 1152
#define T_WOUTE 512
#define T_WGLU 128
#define T_WINO 512
#define T_WOUTO 512
#define T_POOL 128
#define N_CONV 256
#define N_TR_ITEMS (T_WINE + T_WOUTE + T_WGLU + T_WINO + T_WOUTO + T_POOL + N_CONV)
#define SETUP_A_END (N_MOD_ITEMS + N_S5_ITEMS + T_WINE + 1)
#define SETUP_B_END (SETUP_A_END + T_WOUTE + T_WGLU)
#define SETUP_C_END (SETUP_B_END + T_WINO + T_WOUTO + T_POOL + N_CONV)

__device__ __forceinline__ void bias_item(const P& p, char* smem, int layer, int nblk, const int wv_) {
  int tid = (wv_ * 64 + lane_id_opaque()); asm volatile("" : "+v"(tid));
  const int lane = tid & 63, w = tid >> 6;
  float* sh = (float*)smem;
  for (int idx = tid; idx < 17 * 1024; idx += NTHREADS) sh[idx] = p.mod[((size_t)layer * 17 + (idx >> 10)) * 3072 + (idx & 1023)];
  __syncthreads();
  const int j2 = layer >> 1;
  const bf16_t* Wt = (layer & 1) ? p.WinO + (size_t)j2 * 2048 * 1024 : p.WinE + (size_t)j2 * 2304 * 1024;
  const int n = nblk * 64 + lane;
  const bf16_t* wr = Wt + (size_t)n * 1024 + w * 128;
  float acc[17];
#pragma unroll
  for (int b = 0; b < 17; ++b) acc[b] = 0.f;
  for (int kc = 0; kc < 16; ++kc) {
    const uint4 wv4 = *(const uint4*)(wr + kc * 8);
    const unsigned ww[4] = {wv4.x, wv4.y, wv4.z, wv4.w};
    float wf[8];
#pragma unroll
    for (int e = 0; e < 4; ++e) { wf[2 * e] = bf2f((bf16_t)(ww[e] & 0xffff)); wf[2 * e + 1] = bf2f((bf16_t)(ww[e] >> 16)); }
    const float* sp = sh + w * 128 + kc * 8;
#pragma unroll
    for (int b = 0; b < 17; ++b)
#pragma unroll
      for (int e = 0; e < 8; ++e) acc[b] += sp[b * 1024 + e] * wf[e];
  }
  __syncthreads();
  float* red = (float*)smem;
#pragma unroll
  for (int b = 0; b < 17; ++b) red[(w * 17 + b) * 64 + lane] = acc[b];
  __syncthreads();
  for (int idx = tid; idx < 17 * 64; idx += NTHREADS) {
    int b = idx >> 6, ln = idx & 63;
    float v = 0.f;
#pragma unroll
    for (int ww2 = 0; ww2 < NWAVES; ++ww2) v += red[(ww2 * 17 + b) * 64 + ln];
    p.bias[((size_t)layer * 17 + b) * 2304 + nblk * 64 + ln] = v;
  }
  __syncthreads();
}
__device__ __forceinline__ void bias_phase(const P& p, char* smem, int which, const int wv_) {
  const int nitems = which == 0 ? 36 : 64;
  for (int it = blockIdx.x; it < nitems; it += gridDim.x) {
    if (which == 0) bias_item(p, smem, 2, it, wv_);
    else bias_item(p, smem, it < 32 ? 1 : 3, it & 31, wv_);
  }
}

__device__ __forceinline__ void setup_phase(const P& p, char* smem, int item_lo, int item_hi, const int wv_) {
  if (item_lo == 0) {
    int tz = (wv_ * 64 + lane_id_opaque()); asm volatile("" : "+v"(tz));
    for (int i = blockIdx.x * NTHREADS + tz; i < 4 * MALL; i += gridDim.x * NTHREADS) p.rowss[i] = 0.f;
  }
  for (int item = item_lo + blockIdx.x; item < item_hi; item += gridDim.x) {
    int it = item;
    if (it < N_MOD_ITEMS) { setup_mod_item(p, smem, it, wv_); continue; }
    it -= N_MOD_ITEMS;
    if (it < N_S5_ITEMS) { setup_s5_item(p, smem, it, wv_); continue; }
    it -= N_S5_ITEMS;
    if (it < T_WINE) { int j = it / 576, t = it % 576; transpose_tile(smem, p.even_w_in + (size_t)j * 1024 * 2304, p.WinE + (size_t)j * 2304 * 1024, 1024, 2304, t, wv_); continue; }
    it -= T_WINE;
    if (it < 1) {
      int tid_ = (wv_ * 64 + lane_id_opaque()); asm volatile("" : "+v"(tid_));
      for (int idx = tid_; idx < 1024; idx += NTHREADS) {
        int pos = idx >> 4, f = idx & 15;
        float inv = powf(10000.0f, -(float)f / 16.0f);
        float ang = (float)pos * inv;
        float sn, cs;
        sincosf(ang, &sn, &cs);
        p.rope[idx * 2] = cs;
        p.rope[idx * 2 + 1] = sn;
      }
      continue;
    }
    it -= 1;
    if (it < T_WOUTE) { int j = it / 256, t = it % 256; transpose_tile(smem, p.even_w_out + (size_t)j * 1024 * 1024, p.WoutE + (size_t)j * 1024 * 1024, 1024, 1024, t, wv_); continue; }
    it -= T_WOUTE;
    if (it < T_WGLU) { int j = it / 64, t = it % 64; transpose_tile(smem, p.glu_w + (size_t)j * 512 * 512, p.Wglu + (size_t)j * 512 * 512, 512, 512, t, wv_); continue; }
    it -= T_WGLU;
    if (it < T_WINO) { int j = it / 256, t = it % 256; transpose_tile(smem, p.odd_w_in + (size_t)j * 1024 * 2048, p.WinO + (size_t)j * 2048 * 1024, 1024, 2048, (t >> 4) * 32 + 16 + (t & 15), wv_); continue; }
    it -= T_WINO;
    if (it < T_WOUTO) { int j = it / 256, t = it % 256; transpose_tile(smem, p.odd_w_out + (size_t)j * 1024 * 1024, p.WoutO + (size_t)j * 1024 * 1024, 1024, 1024, t, wv_); continue; }
    it -= T_WOUTO;
    if (it < T_POOL) { int jg = it / 16, t = it % 16; transpose_tile(smem, p.pool_w + (size_t)jg * 65536, p.Wpool + (size_t)jg * 65536, 256, 256, t, wv_); continue; }
    it -= T_POOL;
    if (it < N_CONV) {
      const int j = it >> 7, r0 = (it & 127) * 8;
      int tid_ = (wv_ * 64 + lane_id_opaque()); asm volatile("" : "+v"(tid_));
      for (int e = tid_; e < 8 * 256; e += NTHREADS) {
        const int r = r0 + (e >> 8), c4 = (e & 255) * 4;
        const float4 v = *(const float4*)(p.odd_w_in + ((size_t)j * 1024 + r) * 2048 + c4);
        uint2 u; u.x = pack2(v.x, v.y); u.y = pack2(v.z, v.w);
        *(uint2*)(p.WuO + ((size_t)j * 1024 + r) * 1024 + c4) = u;
      }
      continue;
    }
  }
}

__device__ __forceinline__ void norm_phase(const P& p, int layer, int Mrows, const int wv_) {
  int tid_ = (wv_ * 64 + lane_id_opaque()); asm volatile("" : "+v"(tid_));
  const int lane = tid_ & 63, w = tid_ >> 6;
  const float* g = p.norm_g + layer * 1024;
  for (int row0 = (blockIdx.x * NWAVES + w) * 2; row0 < Mrows; row0 += gridDim.x * NWAVES * 2) {
    float4 v[2][4];
    float ss[2] = {0.f, 0.f};
#pragma unroll
    for (int r = 0; r < 2; ++r) {
      const float* src = hin_row(p, layer, row0 + r);
#pragma unroll
      for (int i = 0; i < 4; ++i) v[r][i] = *(const float4*)(src + i * 256 + lane * 4);
    }
#pragma unroll
    for (int r = 0; r < 2; ++r)
#pragma unroll
      for (int i = 0; i < 4; ++i) ss[r] += v[r][i].x * v[r][i].x + v[r][i].y * v[r][i].y + v[r][i].z * v[r][i].z + v[r][i].w * v[r][i].w;
#pragma unroll
    for (int o = 32; o; o >>= 1) { ss[0] += shflx(ss[0], o, lane); ss[1] += shflx(ss[1], o, lane); }
#pragma unroll
    for (int r = 0; r < 2; ++r) {
      const int row = row0 + r;
      const float rstd = rsqrtf(ss[r] * (1.0f / 1024.0f) + 1e-6f);
      const int b = row < NLAT ? (row >> 12) : 16;
      const float* md = p.mod + ((size_t)layer * 17 + b) * 3072;
      bf16_t* dst = p.abuf + (size_t)row * DM;
#pragma unroll
      for (int i = 0; i < 4; ++i) {
        int col = i * 256 + lane * 4;
        float4 gg = *(const float4*)(g + col);
        float4 sh = *(const float4*)(md + col);
        float4 sc = *(const float4*)(md + 1024 + col);
        float a0 = v[r][i].x * rstd * gg.x * (1.0f + sc.x) + sh.x;
        float a1 = v[r][i].y * rstd * gg.y * (1.0f + sc.y) + sh.y;
        float a2 = v[r][i].z * rstd * gg.z * (1.0f + sc.z) + sh.z;
        float a3 = v[r][i].w * rstd * gg.w * (1.0f + sc.w) + sh.w;
        uint2 o2;
        o2.x = pack2(a0, a1);
        o2.y = pack2(a2, a3);
        *(uint2*)(dst + col) = o2;
      }
    }
  }
}

__device__ __forceinline__ void final_phase(const P& p, const int wv_) {
  int tid_ = (wv_ * 64 + lane_id_opaque()); asm volatile("" : "+v"(tid_));
  const int lane = tid_ & 63, w = tid_ >> 6;
  for (int row0 = (blockIdx.x * NWAVES + w) * 2; row0 < NLAT; row0 += gridDim.x * NWAVES * 2) {
    float4 v[2][4];
    float ss[2] = {0.f, 0.f};
#pragma unroll
    for (int r = 0; r < 2; ++r) {
      const float* src = p.out + (size_t)(row0 + r) * DM;
#pragma unroll
      for (int i = 0; i < 4; ++i) v[r][i] = *(const float4*)(src + i * 256 + lane * 4);
    }
#pragma unroll
    for (int r = 0; r < 2; ++r)
#pragma unroll
      for (int i = 0; i < 4; ++i) ss[r] += v[r][i].x * v[r][i].x + v[r][i].y * v[r][i].y + v[r][i].z * v[r][i].z + v[r][i].w * v[r][i].w;
#pragma unroll
    for (int o = 32; o; o >>= 1) { ss[0] += shflx(ss[0], o, lane); ss[1] += shflx(ss[1], o, lane); }
#pragma unroll
    for (int r = 0; r < 2; ++r) {
      float* dst = p.out + (size_t)(row0 + r) * DM;
      const float rstd = rsqrtf(ss[r] * (1.0f / 1024.0f) + 1e-6f);
#pragma unroll
      for (int i = 0; i < 4; ++i) {
        int col = i * 256 + lane * 4;
        float4 gg = *(const float4*)(p.final_g + col);
        float4 o4 = make_float4(v[r][i].x * rstd * gg.x, v[r][i].y * rstd * gg.y, v[r][i].z * rstd * gg.z, v[r][i].w * rstd * gg.w);
        *(float4*)(dst + col) = o4;
      }
    }
  }
}

enum { EPI_EVEN_IN = 0, EPI_BF16 = 1, EPI_S5_S = 2, EPI_S5_Y = 3, EPI_GLU = 4, EPI_POOL = 5, EPI_RESID = 6, EPI_MERGE = 7 };

template <int EPI>
__device__ __forceinline__ void epi_frag(const P& p, int layer, int bt, int row, int col, const f32x4 a) {
  const int j2 = layer >> 1;
  if (EPI == EPI_EVEN_IN) {
    uint2 u;
    u.x = pack2(a[0], a[1]);
    u.y = pack2(a[2], a[3]);
    if (col >= 1280 && col < 1792) {
      const int cu = col - 1280, g = cu >> 4, c = cu & 15;
      int b, i;
      if (row < NLAT) { b = row >> 12; i = 256 + (row & 4095); } else { b = (row - NLAT) >> 8; i = (row - NLAT) & 255; }
      const int kap = i >> 4, sg = i & 15;
      *(uint2*)(p.XH + ((size_t)(g * 4352 + b * 272 + kap)) * 512 + sg * 16 + c) = u;
    } else {
      *(uint2*)(p.proj + (size_t)row * LDP + col) = u;
    }
  } else if (EPI == EPI_BF16) {
    uint2 u; u.x = pack2(a[0], a[1]); u.y = pack2(a[2], a[3]);
    *(uint2*)(p.proj + (size_t)row * LDO + col) = u;
  } else if (EPI == EPI_S5_S) {
    { uint2 u; u.x = pack2(a[0], a[1]); u.y = pack2(a[2], a[3]);
      *(uint2*)((bf16_t*)p.Sbuf + ((size_t)bt * 4352 + row) * 256 + col) = u; }
  } else if (EPI == EPI_S5_Y) {
    const int b = row / 272, kap = row % 272, tau = col >> 4, co = col & 15;
    const int i = kap * 16 + tau;
    const int trow = i < 256 ? NLAT + b * 256 + i : b * 4096 + (i - 256);
    uint2 uu = *(const uint2*)(p.XH + ((size_t)bt * 4352 + row) * 512 + col);
    const float4 dd = *(const float4*)(p.ssm_d + j2 * 512 + bt * 16 + co);
    float y0 = a[0] + bf2f((bf16_t)(uu.x & 0xffff)) * dd.x;
    float y1 = a[1] + bf2f((bf16_t)(uu.x >> 16)) * dd.y;
    float y2 = a[2] + bf2f((bf16_t)(uu.y & 0xffff)) * dd.z;
    float y3 = a[3] + bf2f((bf16_t)(uu.y >> 16)) * dd.w;
    uint2 u; u.x = pack2(geluf_(y0), geluf_(y1)); u.y = pack2(geluf_(y2), geluf_(y3));
    *(uint2*)(p.bbuf + (size_t)trow * 512 + bt * 16 + co) = u;
  } else if (EPI == EPI_GLU) {
    uint2 zz = *(const uint2*)(p.bbuf + (size_t)row * 512 + col);
    uint2 gg = *(const uint2*)(p.proj + (size_t)row * LDP + 1792 + col);
    const float4 gb = *(const float4*)(p.glu_b + j2 * 512 + col);
    float r0 = bf2f((bf16_t)(zz.x & 0xffff)) * sigmoidf_(a[0] + gb.x) * siluf_(bf2f((bf16_t)(gg.x & 0xffff)));
    float r1 = bf2f((bf16_t)(zz.x >> 16)) * sigmoidf_(a[1] + gb.y) * siluf_(bf2f((bf16_t)(gg.x >> 16)));
    float r2 = bf2f((bf16_t)(zz.y & 0xffff)) * sigmoidf_(a[2] + gb.z) * siluf_(bf2f((bf16_t)(gg.y & 0xffff)));
    float r3 = bf2f((bf16_t)(zz.y >> 16)) * sigmoidf_(a[3] + gb.w) * siluf_(bf2f((bf16_t)(gg.y >> 16)));
    uint2 u; u.x = pack2(r0, r1); u.y = pack2(r2, r3);
    *(uint2*)(p.abuf + (size_t)row * DM + 512 + col) = u;
  } else if (EPI == EPI_POOL) {
    uint2 gg = *(const uint2*)(p.proj + (size_t)row * LDO + 1024 + col);
    const float4 ps = *(const float4*)(p.pool_scale + j2 * 1024 + col);
    float r0 = a[0] * ps.x * siluf_(bf2f((bf16_t)(gg.x & 0xffff)));
    float r1 = a[1] * ps.y * siluf_(bf2f((bf16_t)(gg.x >> 16)));
    float r2 = a[2] * ps.z * siluf_(bf2f((bf16_t)(gg.y & 0xffff)));
    float r3 = a[3] * ps.w * siluf_(bf2f((bf16_t)(gg.y >> 16)));
    uint2 u; u.x = pack2(r0, r1); u.y = pack2(r2, r3);
    *(uint2*)(p.bbuf + (size_t)row * DM + col) = u;
  } else if (EPI == EPI_MERGE) {
    bf16_t* d = p.WinO + ((size_t)bt * 2048 + col) * 1024 + row;
    d[0] = f2bf(a[0]); d[1024] = f2bf(a[1]); d[2048] = f2bf(a[2]); d[3072] = f2bf(a[3]);
  } else if (EPI == EPI_RESID) {
    const int b = row < NLAT ? (row >> 12) : 16;
    const float4 gt = *(const float4*)(p.mod + ((size_t)layer * 17 + b) * 3072 + 2048 + col);
    const float4 hv = *(const float4*)(hin_row(p, layer, row) + col);
    float4 o4 = make_float4(hv.x + gt.x * a[0], hv.y + gt.y * a[1], hv.z + gt.z * a[2], hv.w + gt.w * a[3]);
    *(float4*)(hout_row(p, row) + col) = o4;
  }
}

template <int EPI>
__device__ __forceinline__ void epi_pair(const P& p, int layer, int bt, int row, int col, int off2, int axis, int fq, const f32x4 a0, const f32x4 a1) {
  if (EPI == EPI_EVEN_IN) {
    if (col < 640 && row < NLAT) {
      const int t = row & 4095;
      const int pos = axis == 0 ? (t >> 6) : (t & 63);
      const float* tb = p.rope + (pos * 16 + fq * 4) * 2;
      const float4 cs0 = *(const float4*)(tb), cs1 = *(const float4*)(tb + 4);
      const float cs[4] = {cs0.x, cs0.z, cs1.x, cs1.z}, sn[4] = {cs0.y, cs0.w, cs1.y, cs1.w};
      float o1[4], o2[4];
#pragma unroll
      for (int jj = 0; jj < 4; ++jj) {
        o1[jj] = a0[jj] * cs[jj] - a1[jj] * sn[jj];
        o2[jj] = a1[jj] * cs[jj] + a0[jj] * sn[jj];
      }
      bf16_t* d1 = p.proj + (size_t)row * LDP + col;
      uint2 u1, u2;
      u1.x = pack2(o1[0], o1[1]); u1.y = pack2(o1[2], o1[3]);
      u2.x = pack2(o2[0], o2[1]); u2.y = pack2(o2[2], o2[3]);
      *(uint2*)d1 = u1;
      *(uint2*)(d1 + 16) = u2;
      return;
    }
  }
  epi_frag<EPI>(p, layer, bt, row, col, a0);
  epi_frag<EPI>(p, layer, bt, row, col + off2, a1);
}

namespace pg8 {
#define PG8_LAS __attribute__((address_space(3)))
constexpr int BM = 256, BK = 64, HALF = 128, HTB = HALF * BK * 2  , STAGE_BYTES = 8 * HTB;
__host__ __device__ __forceinline__ int lds_byte(int r, int c) { const int st = (r >> 4) * 2 + (c >> 5), rr = r & 15, cc = c & 31, ob = rr * 64 + cc * 2; return st * 1024 + (ob ^ (((ob >> 9) & 1) << 5)); }
__host__ __device__ __forceinline__ void stage_rc(int b, int& R, int& C) { const int st = b / 1024, sb = b % 1024, swz = sb ^ (((sb >> 9) & 1) << 5); R = (st >> 1) * 16 + swz / 64; C = (st & 1) * 32 + (swz % 64) / 2; }
__host__ __device__ __forceinline__ int perm32(int rho) { const int n = rho >> 4, i = rho & 15; return 8 * (i >> 2) + 4 * n + (i & 3); }
struct Unit { int pm, pn, pb, ka; };
struct Gemm { const bf16_t* A; const bf16_t* Bt; int lda, ldb, K; };
struct BandOrder {
    int tilesN, tilesMb, Rx, Tx, nxb, xcd, lb, pool;
    __device__ void init(int Rtot, int tilesN_, int tilesMb_, int pool_, int lbshift) { tilesN = tilesN_; tilesMb = tilesMb_; pool = pool_; nxb = gridDim.x >> 3; xcd = blockIdx.x & 7;
        lb = ((int)(blockIdx.x >> 3) + lbshift) % nxb;
        Rx = Rtot >> 3; Tx = Rx * tilesN; }
    __device__ bool next(int i, Unit& u) const {
        const int L = lb + i * nxb; if (L >= Tx) return false;
        const int rt = xcd * Rx + L / tilesN, nt = L % tilesN;
        u.pm = rt; u.pn = nt; u.pb = (rt / tilesMb) * tilesN + nt; u.ka = pool ? nt * 256 : 0; return true;
    }
    __device__ __forceinline__ void a_ready(const Unit&) const {}
    __device__ __forceinline__ void done(const Unit&) const {}
};
template <class Epi, class Sched, bool ALIGN_EPI = false, bool SP2 = false>
__device__ __forceinline__ void gemm_phase(PG8_LAS unsigned char* lds, const Gemm g, const Sched& S, const Epi& E, const int wv_) {
    int tid = (wv_ * 64 + lane_id_opaque()); asm volatile("" : "+v"(tid)); const int wid = __builtin_amdgcn_readfirstlane(tid >> 6), lane = tid & 63, wr = wid >> 2, wc = wid & 3, fr = lane & 15, fq = lane >> 4;
    const int K = g.K, nt = K / BK, lda = g.lda, ldb = g.ldb;
    unsigned voffA[2], voffB[2];
#pragma unroll
    for (int i = 0; i < 2; ++i) { int R, C; stage_rc(tid * 16 + i * 8192, R, C); const int Rb = Epi::PERM ? ((R & ~31) + perm32(R & 31)) : R;
        voffA[i] = (unsigned)(R * lda + C) * 2u; voffB[i] = (unsigned)(Rb * ldb + C) * 2u; }
    const size_t kstep = (size_t)(BK * 2);
    const size_t hstepA = (size_t)HALF * lda * 2, hstepB = (size_t)HALF * ldb * 2;
    const unsigned ldsw = (unsigned)wid * 1024u;
    const int aoff = lds_byte(wr * 64 + fr, fq * 8), boff = lds_byte(wc * 32 + fr, fq * 8);
#define PG8_SA(b, h) (((b) * 2 + (h)) * HTB)
#define PG8_SB(b, h) ((4 + (b) * 2 + (h)) * HTB)
#define PG8_STAGE(bufoff, gbase, voff) do { _Pragma("unroll") for (int _i = 0; _i < 2; ++_i) \
        __builtin_amdgcn_global_load_lds((const unsigned*)((const char*)(gbase) + (voff)[_i]), (PG8_LAS unsigned*)(lds + (bufoff) + ldsw + _i * 8192), 16, 0, 0); } while (0)
#define PG8_LDA(dst, b, h) do { _Pragma("unroll") for (int m = 0; m < 4; ++m) _Pragma("unroll") for (int k = 0; k < 2; ++k) dst[m][k] = *(const PG8_LAS bf16x8*)(lds + PG8_SA(b, h) + aoff + m * 2048 + k * 1024); } while (0)
#define PG8_LDB(dst, b, h) do { _Pragma("unroll") for (int n = 0; n < 2; ++n) _Pragma("unroll") for (int k = 0; k < 2; ++k) dst[n][k] = *(const PG8_LAS bf16x8*)(lds + PG8_SB(b, h) + boff + n * 2048 + k * 1024); } while (0)
#define PG8_MMA(ai, bj, At, Bt) do { __builtin_amdgcn_s_setprio(1); _Pragma("unroll") for (int m = 0; m < 4; ++m) _Pragma("unroll") for (int n = 0; n < 2; ++n) _Pragma("unroll") for (int k = 0; k < 2; ++k) \
        acc[ai][bj][m][n] = __builtin_amdgcn_mfma_f32_16x16x32_bf16(Bt[n][k], At[m][k], acc[ai][bj][m][n], 0, 0, 0); __builtin_amdgcn_s_setprio(0); } while (0)
#define PG8_WAIT_V(n) asm volatile("s_waitcnt vmcnt(" #n ")" ::: "memory")
#define PG8_WAIT_L(n) asm volatile("s_waitcnt lgkmcnt(" #n ")" ::: "memory")
#define PG8_BAR __builtin_amdgcn_s_barrier()
#define PG8_SCHED __builtin_amdgcn_sched_barrier(0)
    Unit cur, nxt; int ui = 0;
    if (!S.next(0, cur)) return;
    f32x4 acc[2][2][4][2];
#pragma unroll
    for (int a = 0; a < 2; ++a)
#pragma unroll
        for (int b = 0; b < 2; ++b)
#pragma unroll
            for (int m = 0; m < 4; ++m)
#pragma unroll
                for (int n = 0; n < 2; ++n) acc[a][b][m][n] = (f32x4){0.f, 0.f, 0.f, 0.f};
    bf16x8 At[4][2], B0[2][2], B1[2][2];
    const char* cA = (const char*)(g.A + (size_t)cur.pm * BM * lda + cur.ka); const char* cB = (const char*)(g.Bt + (size_t)cur.pb * BM * ldb);
    S.a_ready(cur);
    if constexpr (SP2) {
        PG8_STAGE(PG8_SB(0, 0), cB, voffB); PG8_STAGE(PG8_SB(0, 1), cB + hstepB, voffB); PG8_STAGE(PG8_SA(0, 0), cA, voffA); PG8_STAGE(PG8_SA(0, 1), cA + hstepA, voffA);
        if (wr == 1) PG8_BAR;
        PG8_WAIT_V(2); PG8_BAR;
        PG8_STAGE(PG8_SB(1, 0), cB + kstep, voffB); PG8_STAGE(PG8_SA(1, 0), cA + kstep, voffA); PG8_STAGE(PG8_SB(1, 1), cB + hstepB + kstep, voffB);
        PG8_WAIT_V(6); PG8_BAR;
    } else {
        PG8_STAGE(PG8_SB(0, 0), cB, voffB); PG8_STAGE(PG8_SA(0, 0), cA, voffA); PG8_STAGE(PG8_SB(0, 1), cB + hstepB, voffB); PG8_STAGE(PG8_SA(0, 1), cA + hstepA, voffA);
        if (wr == 1) PG8_BAR;
        PG8_WAIT_V(4); PG8_BAR;
        PG8_STAGE(PG8_SB(1, 0), cB + kstep, voffB); PG8_STAGE(PG8_SA(1, 0), cA + kstep, voffA); PG8_STAGE(PG8_SB(1, 1), cB + hstepB + kstep, voffB);
        PG8_WAIT_V(6); PG8_BAR;
    }
    for (;;) {
        const bool has_next = S.next(ui + 1, nxt);
        const char* nA = has_next ? (const char*)(g.A + (size_t)nxt.pm * BM * lda + nxt.ka) : cA; const char* nB = has_next ? (const char*)(g.Bt + (size_t)nxt.pb * BM * ldb) : cB;
        for (int t = 0; t < nt; t += 2) {
            const bool last = (t == nt - 2);
            const char* a1 = cA + (size_t)(t + 1) * kstep;
            const char* a2 = last ? nA : cA + (size_t)(t + 2) * kstep; const char* b2 = last ? nB : cB + (size_t)(t + 2) * kstep;
            const char* a3 = a2 + kstep; const char* b3 = b2 + kstep;
            if (last && has_next) S.a_ready(nxt);
            if constexpr (SP2) {
            PG8_LDB(B0, 0, 0); PG8_LDB(B1, 0, 1); PG8_SCHED; PG8_LDA(At, 0, 0); PG8_STAGE(PG8_SA(1, 1), a1 + hstepA, voffA);
            PG8_WAIT_V(8); PG8_WAIT_L(0); PG8_BAR; PG8_MMA(0, 0, At, B0); PG8_MMA(0, 1, At, B1); PG8_BAR; PG8_SCHED;
            PG8_LDA(At, 0, 1); PG8_STAGE(PG8_SB(0, 0), b2, voffB); PG8_STAGE(PG8_SB(0, 1), b2 + hstepB, voffB); PG8_STAGE(PG8_SA(0, 0), a2, voffA);
            PG8_WAIT_V(8); PG8_WAIT_L(0); PG8_BAR; PG8_MMA(1, 0, At, B0); PG8_MMA(1, 1, At, B1); PG8_BAR; PG8_SCHED;
            PG8_LDB(B0, 1, 0); PG8_LDB(B1, 1, 1); PG8_SCHED; PG8_LDA(At, 1, 0); PG8_STAGE(PG8_SA(0, 1), a2 + hstepA, voffA);
            PG8_WAIT_V(8); PG8_WAIT_L(0); PG8_BAR; PG8_MMA(0, 0, At, B0); PG8_MMA(0, 1, At, B1); PG8_BAR; PG8_SCHED;
            PG8_LDA(At, 1, 1); PG8_STAGE(PG8_SB(1, 0), b3, voffB); PG8_STAGE(PG8_SB(1, 1), b3 + hstepB, voffB); PG8_STAGE(PG8_SA(1, 0), a3, voffA);
            PG8_WAIT_V(8); PG8_WAIT_L(0); PG8_BAR; PG8_MMA(1, 0, At, B0); PG8_MMA(1, 1, At, B1); PG8_BAR; PG8_SCHED;
            } else {
            PG8_LDB(B0, 0, 0); PG8_SCHED; PG8_LDA(At, 0, 0); PG8_STAGE(PG8_SA(1, 1), a1 + hstepA, voffA);
            PG8_WAIT_L(8); PG8_BAR; PG8_WAIT_L(0); PG8_MMA(0, 0, At, B0); PG8_BAR; PG8_SCHED;
            PG8_LDB(B1, 0, 1); PG8_STAGE(PG8_SB(0, 0), b2, voffB);
            PG8_BAR; PG8_WAIT_L(0); PG8_MMA(0, 1, At, B1); PG8_BAR;
            PG8_LDA(At, 0, 1); PG8_STAGE(PG8_SA(0, 0), a2, voffA);
            PG8_BAR; PG8_WAIT_L(0); PG8_MMA(1, 0, At, B0); PG8_BAR; PG8_SCHED;
            PG8_STAGE(PG8_SB(0, 1), b2 + hstepB, voffB);
            PG8_WAIT_V(6); PG8_BAR; PG8_MMA(1, 1, At, B1); PG8_BAR;
            PG8_LDB(B0, 1, 0); PG8_SCHED; PG8_LDA(At, 1, 0); PG8_STAGE(PG8_SA(0, 1), a2 + hstepA, voffA);
            PG8_WAIT_L(8); PG8_BAR; PG8_WAIT_L(0); PG8_MMA(0, 0, At, B0); PG8_BAR; PG8_SCHED;
            PG8_LDB(B1, 1, 1); PG8_STAGE(PG8_SB(1, 0), b3, voffB);
            PG8_BAR; PG8_WAIT_L(0); PG8_MMA(0, 1, At, B1); PG8_BAR;
            PG8_LDA(At, 1, 1); PG8_STAGE(PG8_SA(1, 0), a3, voffA);
            PG8_BAR; PG8_WAIT_L(0); PG8_MMA(1, 0, At, B0); PG8_BAR; PG8_SCHED;
            PG8_STAGE(PG8_SB(1, 1), b3 + hstepB, voffB);
            PG8_WAIT_V(6); PG8_BAR; PG8_MMA(1, 1, At, B1); PG8_BAR;
            }
        }
        if constexpr (ALIGN_EPI) { if (wr == 0) PG8_BAR; }
        if constexpr (!Epi::AFTER_DRAIN) { E(acc, cur, wr, wc, fr, fq); S.done(cur); }
        if (!has_next) break;
#pragma unroll
        for (int a = 0; a < 2; ++a)
#pragma unroll
            for (int b = 0; b < 2; ++b)
#pragma unroll
                for (int m = 0; m < 4; ++m)
#pragma unroll
                    for (int n = 0; n < 2; ++n) acc[a][b][m][n] = (f32x4){0.f, 0.f, 0.f, 0.f};
        cur = nxt; cA = nA; cB = nB; ++ui;
        if constexpr (ALIGN_EPI) { if (wr == 1) PG8_BAR; }
    }
    PG8_WAIT_V(0);
    if constexpr (!ALIGN_EPI) { if (wr == 0) PG8_BAR; }
    PG8_BAR;
    if constexpr (Epi::AFTER_DRAIN) { E.fused(acc, cur, wr, wc, fr, fq, lds, wid, lane); S.done(cur); }
#undef PG8_SA
#undef PG8_SB
#undef PG8_STAGE
#undef PG8_LDA
#undef PG8_LDB
#undef PG8_MMA
#undef PG8_WAIT_V
#undef PG8_WAIT_L
#undef PG8_BAR
#undef PG8_SCHED
}
}

template <int EPI> struct MyEpi {
    static constexpr bool PERM = (EPI == EPI_GLU || EPI == EPI_S5_Y || EPI == EPI_S5_S), AFTER_DRAIN = false;
    const P* pp; int layer, tilesMb;
    __device__ __forceinline__ void operator()(const f32x4 (&acc)[2][2][4][2], const pg8::Unit& u, int wr, int wc, int fr, int fq) const {
        const P& p = *pp;
        const int bt = u.pm / tilesMb;
        const int rowt = (u.pm - bt * tilesMb) * 256;
#pragma unroll
        for (int ai = 0; ai < 2; ++ai)
#pragma unroll
            for (int m = 0; m < 4; ++m) {
                const int row = rowt + ai * 128 + wr * 64 + m * 16 + fr;
                float rstd = 1.0f;
                if ((EPI == EPI_EVEN_IN || EPI == EPI_BF16) && layer > 0) rstd = rsqrtf(p.rowss[(size_t)layer * MALL + row] * (1.0f / 1024.0f) + 1e-6f);
#pragma unroll
                for (int bj = 0; bj < 2; ++bj) {
                    const int col = u.pn * 256 + bj * 128 + wc * 32 + (PERM ? fq * 8 : fq * 4);
                    f32x4 a0 = acc[ai][bj][m][0], a1 = acc[ai][bj][m][1];
                    if ((EPI == EPI_EVEN_IN || EPI == EPI_BF16) && layer > 0) {
                        const float* bp = p.bias + ((size_t)layer * 17 + (rowt < NLAT ? (rowt >> 12) : 16)) * 2304 + col;
                        a0 = a0 * rstd + *(const f32x4*)(bp);
                        a1 = a1 * rstd + *(const f32x4*)(bp + 16);
                    }
                    epi_pair<EPI>(p, layer, bt, row, col, PERM ? 4 : 16, wc & 1, fq, a0, a1);
                }
            }
    }
};

template <> struct MyEpi<EPI_EVEN_IN> {
    static constexpr bool PERM = true, AFTER_DRAIN = false;
    const P* pp; int layer, tilesMb;
    __device__ __forceinline__ void operator()(const f32x4 (&acc)[2][2][4][2], const pg8::Unit& u, int wr, int wc, int fr, int fq) const {
        const P& p = *pp;
        const int rowt = u.pm * 256;
        const int lane_ = fq * 16 + fr;
        const int col0 = u.pn * 256 + wc * 32 + fq * 8;
        const bool latent = rowt < NLAT;
        f32x4 bv[2][2];
        if (layer > 0) {
            const float* bp = p.bias + ((size_t)layer * 17 + (latent ? (rowt >> 12) : 16)) * 2304 + col0;
#pragma unroll
            for (int bj = 0; bj < 2; ++bj)
#pragma unroll
                for (int n = 0; n < 2; ++n) bv[bj][n] = *(const f32x4*)(bp + bj * 128 + n * 4);
        }
#pragma unroll
        for (int ai = 0; ai < 2; ++ai)
#pragma unroll
            for (int m = 0; m < 4; ++m) {
                const int row = rowt + ai * 128 + wr * 64 + m * 16 + fr;
                float rstd = 1.0f;
                if (layer > 0) rstd = rsqrtf(p.rowss[(size_t)layer * MALL + row] * (1.0f / 1024.0f) + 1e-6f);
#pragma unroll
                for (int bj = 0; bj < 2; ++bj) {
                    const int colb = col0 + bj * 128;
                    f32x4 v0 = acc[ai][bj][m][0], v1 = acc[ai][bj][m][1];
                    if (layer > 0) { v0 = v0 * rstd + bv[bj][0]; v1 = v1 * rstd + bv[bj][1]; }
                    if (colb < 640 && latent) {
                        const int t = row & 4095;
                        const int pos = (wc & 1) == 0 ? (t >> 6) : (t & 63);
                        const float* tb = p.rope + (pos * 16 + 8 * (fq & 1)) * 2;
                        const f32x4 t0 = *(const f32x4*)(tb), t1 = *(const f32x4*)(tb + 4), t2 = *(const f32x4*)(tb + 8), t3 = *(const f32x4*)(tb + 12);
                        const float cs[8] = {t0[0], t0[2], t1[0], t1[2], t2[0], t2[2], t3[0], t3[2]};
                        const float sn[8] = {t0[1], t0[3], t1[1], t1[3], t2[1], t2[3], t3[1], t3[3]};
                        const float sg = (fq >> 1) ? 1.0f : -1.0f;
                        float o[8];
#pragma unroll
                        for (int j = 0; j < 4; ++j) {
                            const float p0 = shflx(v0[j], 32, lane_), p1 = shflx(v1[j], 32, lane_);
                            o[j] = v0[j] * cs[j] + sg * p0 * sn[j];
                            o[4 + j] = v1[j] * cs[4 + j] + sg * p1 * sn[4 + j];
                        }
                        *(uint4*)(p.proj + (size_t)row * LDP + colb) = make_uint4(pack2(o[0], o[1]), pack2(o[2], o[3]), pack2(o[4], o[5]), pack2(o[6], o[7]));
                    } else {
                        const uint4 w4 = make_uint4(pack2(v0[0], v0[1]), pack2(v0[2], v0[3]), pack2(v1[0], v1[1]), pack2(v1[2], v1[3]));
                        if (colb >= 1280 && colb < 1792) {
                            const int cu = colb - 1280, g = cu >> 4, c = cu & 15;
                            int b, i;
                            if (latent) { b = row >> 12; i = 256 + (row & 4095); } else { b = (row - NLAT) >> 8; i = (row - NLAT) & 255; }
                            *(uint4*)(p.XH + ((size_t)(g * 4352 + b * 272 + (i >> 4))) * 512 + (i & 15) * 16 + c) = w4;
                        } else {
                            *(uint4*)(p.proj + (size_t)row * LDP + colb) = w4;
                        }
                    }
                }
            }
    }
};

template <> struct MyEpi<EPI_BF16> {
    static constexpr bool PERM = true, AFTER_DRAIN = false;
    const P* pp; int layer, tilesMb;
    __device__ __forceinline__ void operator()(const f32x4 (&acc)[2][2][4][2], const pg8::Unit& u, int wr, int wc, int fr, int fq) const {
        const P& p = *pp;
        const int rowt = u.pm * 256;
        const int col0 = u.pn * 256 + wc * 32 + fq * 8;
        const float* bp = p.bias + ((size_t)layer * 17 + (rowt < NLAT ? (rowt >> 12) : 16)) * 2304 + col0;
        f32x4 bv[2][2];
#pragma unroll
        for (int bj = 0; bj < 2; ++bj)
#pragma unroll
            for (int n = 0; n < 2; ++n) bv[bj][n] = *(const f32x4*)(bp + bj * 128 + n * 4);
#pragma unroll
        for (int ai = 0; ai < 2; ++ai)
#pragma unroll
            for (int m = 0; m < 4; ++m) {
                const int row = rowt + ai * 128 + wr * 64 + m * 16 + fr;
                const float rstd = rsqrtf(p.rowss[(size_t)layer * MALL + row] * (1.0f / 1024.0f) + 1e-6f);
#pragma unroll
                for (int bj = 0; bj < 2; ++bj) {
                    const f32x4 v0 = acc[ai][bj][m][0] * rstd + bv[bj][0], v1 = acc[ai][bj][m][1] * rstd + bv[bj][1];
                    uint4 w4 = make_uint4(pack2(v0[0], v0[1]), pack2(v0[2], v0[3]), pack2(v1[0], v1[1]), pack2(v1[2], v1[3]));
                    *(uint4*)(p.proj + (size_t)row * LDO + col0 + bj * 128) = w4;
                }
            }
    }
};

template <> struct MyEpi<EPI_RESID> {
    static constexpr bool PERM = true, AFTER_DRAIN = false;
    const P* pp; int layer, tilesMb;
    __device__ __forceinline__ void operator()(const f32x4 (&acc)[2][2][4][2], const pg8::Unit& u, int wr, int wc, int fr, int fq) const {
        const P& p = *pp;
        const int rowt = u.pm * 256;
        const int b = rowt < NLAT ? (rowt >> 12) : 16;
        const float* hin = hin_row(p, layer, rowt);
        float* hout = hout_row(p, rowt);
        const int col0 = u.pn * 256 + wc * 32 + fq * 8;
        const float* gp = p.mod + ((size_t)layer * 17 + b) * 3072 + 2048 + col0;
        f32x4 gt[2][2], gm[2][2];
        const int lane_ = fq * 16 + fr;
        const int ln = layer < 3 ? layer + 1 : 3;
        bf16_t* hb = ((layer & 1) ? p.abuf : p.bbuf) + (size_t)rowt * DM;
#pragma unroll
        for (int bj = 0; bj < 2; ++bj)
#pragma unroll
            for (int n = 0; n < 2; ++n) {
                gt[bj][n] = *(const f32x4*)(gp + bj * 128 + n * 4);
                const f32x4 ng = *(const f32x4*)(p.norm_g + ln * 1024 + col0 + bj * 128 + n * 4);
                const f32x4 sc = *(const f32x4*)(p.mod + ((size_t)ln * 17 + b) * 3072 + 1024 + col0 + bj * 128 + n * 4);
                gm[bj][n] = ng * (sc + 1.0f);
            }
#pragma unroll
        for (int ai = 0; ai < 2; ++ai)
#pragma unroll
            for (int m = 0; m < 4; ++m) {
                f32x4 hv[2][2];
                float rs = 0.f;
                const int rloc = ai * 128 + wr * 64 + m * 16 + fr;
                const size_t ro = (size_t)rloc * DM + col0;
#pragma unroll
                for (int bj = 0; bj < 2; ++bj)
#pragma unroll
                    for (int n = 0; n < 2; ++n) hv[bj][n] = *(const f32x4*)(hin + ro + bj * 128 + n * 4);
#pragma unroll
                for (int bj = 0; bj < 2; ++bj)
#pragma unroll
                    for (int n = 0; n < 2; ++n) {
                        const f32x4 o = hv[bj][n] + gt[bj][n] * acc[ai][bj][m][n];
                        *(f32x4*)(hout + ro + bj * 128 + n * 4) = o;
                        if (layer < 3) {
                            const f32x4 q = o * gm[bj][n];
                            uint2 w2; w2.x = pack2(q[0], q[1]); w2.y = pack2(q[2], q[3]);
                            *(uint2*)(hb + ro + bj * 128 + n * 4) = w2;
                            rs += o[0] * o[0] + o[1] * o[1] + o[2] * o[2] + o[3] * o[3];
                        }
                    }
                if (layer < 3) {
                    rs += shflx(rs, 16, lane_); rs += shflx(rs, 32, lane_);
                    if (fq == 0) atomicAdd(p.rowss + (size_t)(layer + 1) * MALL + rowt + rloc, rs);
                }
            }
    }
};

template <int EPI>
__device__ __forceinline__ void run_gemm(const P& p, char* smem, const bf16_t* A, int lda, const bf16_t* Bt, int ldb, int Mrows, int N, int K, int nbatch, int layer, const int wv_) {
    pg8::Gemm g; g.A = A; g.Bt = Bt; g.lda = lda; g.ldb = ldb; g.K = K;
    pg8::BandOrder S; S.init(nbatch * (Mrows >> 8), N >> 8, Mrows >> 8, (EPI == EPI_POOL || EPI == EPI_MERGE) ? 1 : 0, (EPI == EPI_S5_S || EPI == EPI_S5_Y || EPI == EPI_GLU) ? 16 : 0);
    MyEpi<EPI> E; E.pp = &p; E.layer = layer; E.tilesMb = Mrows >> 8;
    pg8::gemm_phase<MyEpi<EPI>, pg8::BandOrder, true, true>((PG8_LAS unsigned char*)smem, g, S, E, wv_);
    __syncthreads();
}

__device__ __forceinline__ void attn_phase(const P& p, char* smem, int j2, int nunits, const int wv_) {
  const bf16_t* proj = p.proj;
  const float SC = 0.125f * 1.4426950408889634f;
  const int nxb_ = gridDim.x >> 3, nlat_ = 1024;
  const int nit_ = (gridDim.x == 256) ? 5 : (nunits + (int)gridDim.x - 1) / (int)gridDim.x;
  for (int ui = 0; ui < nit_; ++ui) {
    int unit;
    if (gridDim.x == 256) {
      if (ui < 4) unit = (blockIdx.x & 7) * 128 + (blockIdx.x >> 3) + nxb_ * ui;
      else unit = nlat_ + blockIdx.x;
    } else unit = blockIdx.x + ui * gridDim.x;
    if (unit >= nunits) break;
    int tid = (wv_ * 64 + lane_id_opaque()); asm volatile("" : "+v"(tid));
    const int lane = tid & 63, w = __builtin_amdgcn_readfirstlane(tid >> 6), lr = lane & 15, lq = lane >> 4;
    const int hk = w >> 2, wl = w & 3, tl = tid & 255;
    int b, qb, qpos0, nloc, ilo;
    size_t qrow0;
    if (unit < 1024) {
      b = unit >> 6; qb = unit & 63;
      qrow0 = (size_t)b * 4096 + qb * 64; qpos0 = qb * 64;
      ilo = 2 - qb; if (ilo < 0) ilo = 0;
      int ihi = 65 - qb; if (ihi > 4) ihi = 4;
      nloc = ihi - ilo + 1;
    } else {
      int u = unit - 1024;
      b = u >> 2; qb = u & 3;
      qrow0 = (size_t)NLAT + b * 256 + qb * 64; qpos0 = 0; nloc = 0; ilo = 0;
    }
    const int h = w;
    const int ntl = 4 + nloc;
    char* sQ = smem + 73728 + w * 9216;
#pragma unroll 1
    for (int i = 0; i < 8; ++i) {
      int c = lane + 64 * i;
      *(uint4*)(sQ + (c >> 3) * 144 + (c & 7) * 16) = *(const uint4*)(proj + (qrow0 + (c >> 3)) * LDP + h * 64 + (c & 7) * 8);
    }
    f32x4 o[4][4];
    float mrun[4], lrun[4];
#pragma unroll
    for (int qi = 0; qi < 4; ++qi) {
      mrun[qi] = -1e30f; lrun[qi] = 0.f;
#pragma unroll
      for (int dt = 0; dt < 4; ++dt) o[qi][dt] = (f32x4){0.f, 0.f, 0.f, 0.f};
    }
    uint4 rk0, rk1, rv0, rv1;
#define TILE_ROW(t, kstart, krow) do { if ((t) < 4) { kstart = -100000; krow = (size_t)NLAT + b * 256 + (t) * 64; } else { kstart = qpos0 - 128 + 64 * (ilo + (t) - 4); krow = (size_t)b * 4096 + kstart; } } while (0)
#define LOAD_TILE_K(krow) do { \
      rk0 = *(const uint4*)(proj + ((krow) + (tl >> 3)) * LDP + 512 + hk * 64 + (tl & 7) * 8); \
      rk1 = *(const uint4*)(proj + ((krow) + 32 + (tl >> 3)) * LDP + 512 + hk * 64 + (tl & 7) * 8); } while (0)
#define LOAD_TILE_V(krow) do { \
      rv0 = *(const uint4*)(proj + ((krow) + lane) * LDP + 640 + hk * 64 + wl * 8); \
      rv1 = *(const uint4*)(proj + ((krow) + lane) * LDP + 640 + hk * 64 + (wl + 4) * 8); } while (0)
#define LOAD_TILE(krow) do { LOAD_TILE_K(krow); LOAD_TILE_V(krow); } while (0)
#define ST_V(sV, d0, rv) do { \
      *(bf16_t*)((sV) + ((d0) + 0) * 144 + lane * 2) = (bf16_t)((rv).x & 0xffff); *(bf16_t*)((sV) + ((d0) + 1) * 144 + lane * 2) = (bf16_t)((rv).x >> 16); \
      *(bf16_t*)((sV) + ((d0) + 2) * 144 + lane * 2) = (bf16_t)((rv).y & 0xffff); *(bf16_t*)((sV) + ((d0) + 3) * 144 + lane * 2) = (bf16_t)((rv).y >> 16); \
      *(bf16_t*)((sV) + ((d0) + 4) * 144 + lane * 2) = (bf16_t)((rv).z & 0xffff); *(bf16_t*)((sV) + ((d0) + 5) * 144 + lane * 2) = (bf16_t)((rv).z >> 16); \
      *(bf16_t*)((sV) + ((d0) + 6) * 144 + lane * 2) = (bf16_t)((rv).w & 0xffff); *(bf16_t*)((sV) + ((d0) + 7) * 144 + lane * 2) = (bf16_t)((rv).w >> 16); } while (0)
#define STORE_TILE(stage) do { char* sK_ = smem + (stage) * 36864 + hk * 18432; char* sV_ = sK_ + 9216; \
      *(uint4*)(sK_ + (tl >> 3) * 144 + (tl & 7) * 16) = rk0; \
      *(uint4*)(sK_ + (32 + (tl >> 3)) * 144 + (tl & 7) * 16) = rk1; \
      ST_V(sV_, wl * 8, rv0); ST_V(sV_, (wl + 4) * 8, rv1); } while (0)
    int kstart_cur, kstart_nxt = 0;
    {
      size_t kr; TILE_ROW(0, kstart_cur, kr);
      LOAD_TILE(kr);
      STORE_TILE(0);
    }
    __syncthreads();
    for (int t = 0; t < ntl; ++t) {
      const bool more = t + 1 < ntl;
      size_t kr_nxt = 0;
      if (more) { TILE_ROW(t + 1, kstart_nxt, kr_nxt); LOAD_TILE_K(kr_nxt); }
      const char* sK = smem + (t & 1) * 36864 + hk * 18432;
      const char* sV = sK + 9216;
      bf16x8 kf[4][2];
#pragma unroll
      for (int k4 = 0; k4 < 4; ++k4)
#pragma unroll
        for (int ks = 0; ks < 2; ++ks) kf[k4][ks] = *(const bf16x8*)(sK + (k4 * 16 + lr) * 144 + ks * 64 + lq * 16);
      const bool masked = (t >= 4) && ((ilo + t - 4) == 0 || (ilo + t - 4) == 4);
      bf16x8 pf[4][2];
      float alpha[4];
#pragma unroll
      for (int qi = 0; qi < 4; ++qi) {
        f32x4 s[4];
        bf16x8 qf[2];
#pragma unroll
        for (int ks = 0; ks < 2; ++ks) qf[ks] = *(const bf16x8*)(sQ + (qi * 16 + lr) * 144 + ks * 64 + lq * 16);
        __builtin_amdgcn_s_setprio(1);
#pragma unroll
        for (int k4 = 0; k4 < 4; ++k4) {
          s[k4] = (f32x4){0.f, 0.f, 0.f, 0.f};
#pragma unroll
          for (int ks = 0; ks < 2; ++ks) s[k4] = __builtin_amdgcn_mfma_f32_16x16x32_bf16(kf[k4][ks], qf[ks], s[k4], 0, 0, 0);
        }
        __builtin_amdgcn_s_setprio(0);
        if (masked) {
          const int qpos = qpos0 + qi * 16 + lr;
#pragma unroll
          for (int k4 = 0; k4 < 4; ++k4)
#pragma unroll
            for (int jj = 0; jj < 4; ++jj) {
              int kp = kstart_cur + k4 * 16 + lq * 4 + jj;
              int df = qpos - kp; if (df < 0) df = -df;
              if (df > 128) s[k4][jj] = -1e30f;
            }
        }
        float mx = -1e30f;
#pragma unroll
        for (int k4 = 0; k4 < 4; ++k4)
#pragma unroll
          for (int jj = 0; jj < 4; ++jj) mx = fmaxf(mx, s[k4][jj]);
        mx = fmaxf(mx, shflx(mx, 16, lane));
        mx = fmaxf(mx, shflx(mx, 32, lane));
        const float mnew = fmaxf(mrun[qi], mx);
        alpha[qi] = __builtin_amdgcn_exp2f((mrun[qi] - mnew) * SC);
        mrun[qi] = mnew;
        const float msc = mnew * SC;
        float ls = 0.f;
#pragma unroll
        for (int k4 = 0; k4 < 4; ++k4)
#pragma unroll
          for (int jj = 0; jj < 4; ++jj) {
            float pv = __builtin_amdgcn_exp2f(__builtin_fmaf(s[k4][jj], SC, -msc));
            s[k4][jj] = pv;
            ls += pv;
          }
        lrun[qi] = lrun[qi] * alpha[qi] + ls;
#pragma unroll
        for (int dt = 0; dt < 4; ++dt) o[qi][dt] = o[qi][dt] * alpha[qi];
#pragma unroll
        for (int kk = 0; kk < 2; ++kk) {
          uint4 pk = make_uint4(pack2(s[2 * kk][0], s[2 * kk][1]), pack2(s[2 * kk][2], s[2 * kk][3]),
                                pack2(s[2 * kk + 1][0], s[2 * kk + 1][1]), pack2(s[2 * kk + 1][2], s[2 * kk + 1][3]));
          pf[qi][kk] = *(bf16x8*)&pk;
        }
      }
      if (more) LOAD_TILE_V(kr_nxt);
#pragma unroll
      for (int dt = 0; dt < 4; ++dt) {
        bf16x8 vf[2];
#pragma unroll
        for (int kk = 0; kk < 2; ++kk) {
          uint2 lo = *(const uint2*)(sV + (dt * 16 + lr) * 144 + ((2 * kk) * 16 + lq * 4) * 2);
          uint2 hi = *(const uint2*)(sV + (dt * 16 + lr) * 144 + ((2 * kk + 1) * 16 + lq * 4) * 2);
          uint4 cmb = make_uint4(lo.x, lo.y, hi.x, hi.y);
          vf[kk] = *(bf16x8*)&cmb;
        }
        __builtin_amdgcn_s_setprio(1);
#pragma unroll
        for (int qi = 0; qi < 4; ++qi) {
#pragma unroll
          for (int kk = 0; kk < 2; ++kk) o[qi][dt] = __builtin_amdgcn_mfma_f32_16x16x32_bf16(vf[kk], pf[qi][kk], o[qi][dt], 0, 0, 0);
        }
        __builtin_amdgcn_s_setprio(0);
      }
      if (more) STORE_TILE((t + 1) & 1);
      kstart_cur = kstart_nxt;
      __syncthreads();
    }
    const float sink2 = p.attn_sink[j2 * 8 + h] * 1.4426950408889634f;
#pragma unroll
    for (int qi = 0; qi < 4; ++qi) {
      float lt = lrun[qi];
      lt += shflx(lt, 16, lane);
      lt += shflx(lt, 32, lane);
      const float inv = __builtin_amdgcn_rcpf(lt + __builtin_amdgcn_exp2f(sink2 - mrun[qi] * SC));
      const size_t row = qrow0 + qi * 16 + lr;
#pragma unroll
      for (int dt = 0; dt < 4; ++dt) {
        const int col = h * 64 + dt * 16 + lq * 4;
        uint2 gg = *(const uint2*)(proj + row * LDP + 768 + col);
        float r0 = o[qi][dt][0] * inv * siluf_(bf2f((bf16_t)(gg.x & 0xffff)));
        float r1 = o[qi][dt][1] * inv * siluf_(bf2f((bf16_t)(gg.x >> 16)));
        float r2 = o[qi][dt][2] * inv * siluf_(bf2f((bf16_t)(gg.y & 0xffff)));
        float r3 = o[qi][dt][3] * inv * siluf_(bf2f((bf16_t)(gg.y >> 16)));
        uint2 u; u.x = pack2(r0, r1); u.y = pack2(r2, r3);
        *(uint2*)(p.abuf + row * DM + col) = u;
      }
    }
  }
}

__device__ __forceinline__ void scan_phase(const P& p, int j2, const int wv_) {
  int tid_ = (wv_ * 64 + lane_id_opaque()); asm volatile("" : "+v"(tid_));
  const int lane = tid_ & 63, w = tid_ >> 6;
  for (int task = w * gridDim.x + blockIdx.x; task < 1024; task += gridDim.x * NWAVES) {
    const int dir = task & 1, b = (task >> 1) & 15, g = task >> 5;
    const float* aTp = p.aT + ((size_t)(j2 * 32 + g) * 2 + dir) * 128 + lane * 2;
    const float ar = aTp[0], ai = aTp[1];
    const bf16_t* S = (const bf16_t*)p.Sbuf + ((size_t)g * 4352 + b * 272) * 256 + dir * 128 + lane;
    bf16_t* H = p.XH + ((size_t)g * 4352 + b * 272) * 512 + 256 + dir * 128 + lane;
    float hr = 0.f, hi = 0.f;
    float sr[16], si[16], nr[16], ni[16];
#pragma unroll
    for (int s = 0; s < 16; ++s) {
      int q = s;
      int kap = dir == 0 ? q : (q < 16 ? 15 - q : 287 - q);
      sr[s] = bf2f(S[(size_t)kap * 256]);
      si[s] = bf2f(S[(size_t)kap * 256 + 64]);
    }
    for (int bt = 0; bt < 17; ++bt) {
      if (bt + 1 < 17) {
#pragma unroll
        for (int s = 0; s < 16; ++s) {
          int q = (bt + 1) * 16 + s;
          int kap = dir == 0 ? q : (q < 16 ? 15 - q : 287 - q);
          nr[s] = bf2f(S[(size_t)kap * 256]);
          ni[s] = bf2f(S[(size_t)kap * 256 + 64]);
        }
      }
#pragma unroll
      for (int s = 0; s < 16; ++s) {
        int q = bt * 16 + s;
        int kap = dir == 0 ? q : (q < 16 ? 15 - q : 287 - q);
        H[(size_t)kap * 512] = f2bf(hr);
        H[(size_t)kap * 512 + 64] = f2bf(hi);
        float t0 = ar * hr - ai * hi + sr[s];
        float t1 = ar * hi + ai * hr + si[s];
        hr = t0; hi = t1;
      }
#pragma unroll
      for (int s = 0; s < 16; ++s) { sr[s] = nr[s]; si[s] = ni[s]; }
    }
  }
}

__device__ __forceinline__ void acc8(float (&S)[8], const uint4 v, const float sgn) {
  const unsigned vv[4] = {v.x, v.y, v.z, v.w};
#pragma unroll
  for (int e = 0; e < 4; ++e) { S[2 * e] += sgn * bf2f((bf16_t)(vv[e] & 0xffff)); S[2 * e + 1] += sgn * bf2f((bf16_t)(vv[e] >> 16)); }
}
template <int R>
__device__ __forceinline__ void pool_run(const P& p, int row0, int cc, int j2) {
  constexpr int NR = 2 * R + 1;
  int base, len;
  if (row0 < NLAT) { base = row0 & ~4095; len = 4096; } else { base = NLAT + ((row0 - NLAT) & ~255); len = 256; }
  const int pos0 = row0 - base;
  const bf16_t* src = p.proj + (size_t)base * LDO + cc * 8;
  uint4 ring[NR];
  float S[8];
#pragma unroll
  for (int e = 0; e < 8; ++e) S[e] = 0.f;
  int cnt = 0;
#pragma unroll
  for (int d = 0; d < NR; ++d) {
    int q = pos0 - R + d;
    const bool ok = (q >= 0) && (q < len);
    q = q < 0 ? 0 : (q >= len ? len - 1 : q);
    uint4 v = *(const uint4*)(src + (size_t)q * LDO);
    if (!ok) v = make_uint4(0u, 0u, 0u, 0u);
    ring[d] = v;
    acc8(S, v, 1.0f);
    cnt += ok ? 1 : 0;
  }
  const float4 ps0 = *(const float4*)(p.pool_scale + j2 * 1024 + cc * 8), ps1 = *(const float4*)(p.pool_scale + j2 * 1024 + cc * 8 + 4);
  const float ps[8] = {ps0.x, ps0.y, ps0.z, ps0.w, ps1.x, ps1.y, ps1.z, ps1.w};
#pragma unroll
  for (int st = 0; st < 16; ++st) {
    const int t = pos0 + st;
    const uint4 cv4 = ring[(st + R) % NR];
    const uint4 gv = *(const uint4*)(src + (size_t)t * LDO + 1024);
    const unsigned cv[4] = {cv4.x, cv4.y, cv4.z, cv4.w}, gg[4] = {gv.x, gv.y, gv.z, gv.w};
    const float inv = 1.0f / (float)cnt;
    unsigned oo[4];
#pragma unroll
    for (int e = 0; e < 4; ++e) {
      float a0 = (S[2 * e] * inv - bf2f((bf16_t)(cv[e] & 0xffff))) * ps[2 * e] * siluf_(bf2f((bf16_t)(gg[e] & 0xffff)));
      float a1 = (S[2 * e + 1] * inv - bf2f((bf16_t)(cv[e] >> 16))) * ps[2 * e + 1] * siluf_(bf2f((bf16_t)(gg[e] >> 16)));
      oo[e] = pack2(a0, a1);
    }
    *(uint4*)(p.bbuf + (size_t)(base + t) * DM + cc * 8) = make_uint4(oo[0], oo[1], oo[2], oo[3]);
    if (st < 15) {
      const int slot = st % NR;
      acc8(S, ring[slot], -1.0f);
      cnt -= (t - R >= 0) ? 1 : 0;
      int qn = t + R + 1;
      const bool okn = qn < len;
      qn = okn ? qn : len - 1;
      uint4 v = *(const uint4*)(src + (size_t)qn * LDO);
      if (!okn) v = make_uint4(0u, 0u, 0u, 0u);
      ring[slot] = v;
      acc8(S, v, 1.0f);
      cnt += okn ? 1 : 0;
    }
  }
}

__device__ __forceinline__ void pool_phase(const P& p, int Mrows, int j2, const int wv_) {
  int tid_ = (wv_ * 64 + lane_id_opaque()); asm volatile("" : "+v"(tid_));
  const int lane = tid_ & 63, w = __builtin_amdgcn_readfirstlane(tid_ >> 6);
  const int nw = Mrows >> 3;
  for (int W = blockIdx.x * NWAVES + w; W < nw; W += gridDim.x * NWAVES) {
    const int gi = W & 3, row0 = ((W >> 2) * 2 + (lane >> 5)) * 16, cc = gi * 32 + (lane & 31);
    if (gi == 0) pool_run<1>(p, row0, cc, j2);
    else if (gi == 1) pool_run<2>(p, row0, cc, j2);
    else if (gi == 2) pool_run<4>(p, row0, cc, j2);
    else pool_run<8>(p, row0, cc, j2);
  }
}

__device__ __forceinline__ void fast_barrier(unsigned* bar, unsigned& epoch, const int wv_) {
  asm volatile("s_waitcnt vmcnt(0) lgkmcnt(0)" ::: "memory");
  __syncthreads();
  ++epoch;
  if (wv_ == 0 && lane_id_opaque() == 0) {
    __builtin_amdgcn_fence(__ATOMIC_RELEASE, "agent");
    const unsigned g = blockIdx.x & 15u;
    const unsigned ngrp = (gridDim.x + 15u - g) >> 4;
    const unsigned ngroups = gridDim.x < 16u ? gridDim.x : 16u;
    const unsigned old = __hip_atomic_fetch_add(bar + 64 + 64 * g, 1u, __ATOMIC_RELAXED, __HIP_MEMORY_SCOPE_AGENT);
    if (old + 1u == ngrp * epoch) {
      __builtin_amdgcn_fence(__ATOMIC_ACQ_REL, "agent");
      __hip_atomic_fetch_add(bar, 1u, __ATOMIC_RELAXED, __HIP_MEMORY_SCOPE_AGENT);
    }
    while (__hip_atomic_load(bar, __ATOMIC_RELAXED, __HIP_MEMORY_SCOPE_AGENT) < ngroups * epoch) __builtin_amdgcn_s_sleep(1);
    __builtin_amdgcn_fence(__ATOMIC_ACQUIRE, "agent");
  }
  __syncthreads();
}

__global__ void __launch_bounds__(NTHREADS, 2) fwd_megakernel(P p_arg) {
  const P& p = *(const P*)__builtin_amdgcn_kernarg_segment_ptr();
  extern __shared__ __attribute__((aligned(16))) char smem[];
  const int wv_ = __builtin_amdgcn_readfirstlane((int)hipThreadIdx_x >> 6);
  cg::grid_group grid = cg::this_grid();
  const int ph_lo = p.ph_lo, ph_hi = p.ph_hi;
  int ph = 0;
#ifdef MULTI_LAUNCH
#define PHASE(...) do { if (ph >= ph_lo && ph < ph_hi) { __VA_ARGS__; } ++ph; } while (0)
#define LAST_PHASE(...) PHASE(__VA_ARGS__)
#else
#if DUP_PHASE >= 0
#define PHASE(...) do { const int nrep_ = (ph == DUP_PHASE) ? 2 : 1; for (int rep_ = 0; rep_ < nrep_; ++rep_) { __VA_ARGS__; fast_barrier(p.bar, epoch_, wv_); } ++ph; } while (0)
#else
#define PHASE(...) do { __VA_ARGS__; fast_barrier(p.bar, epoch_, wv_); } while (0)
#endif
#define LAST_PHASE(...) do { __VA_ARGS__; } while (0)
#endif
  unsigned epoch_ = 0;
#ifdef MULTI_LAUNCH
  PHASE(setup_phase(p, smem, 0, SETUP_A_END, wv_));
#else
  setup_phase(p, smem, 0, SETUP_A_END, wv_);
  grid.sync();
#endif
  for (int layer = 0; layer < 4; ++layer) {
    const int j2 = layer >> 1;
    const int Mrows = layer == 3 ? NLAT : MALL;
    const int Mout = layer >= 2 ? NLAT : MALL;
    if (layer == 0) {
      PHASE(norm_phase(p, layer, Mrows, wv_);
            setup_phase(p, smem, SETUP_A_END, SETUP_B_END, wv_);
            bias_phase(p, smem, 0, wv_));
    }
    const bf16_t* Ain = layer == 0 ? p.abuf : ((layer & 1) ? p.bbuf : p.abuf);
    if ((layer & 1) == 0) {
      PHASE(run_gemm<EPI_EVEN_IN>(p, smem, Ain, DM, p.WinE + (size_t)j2 * 2304 * 1024, 1024, Mrows, 2304, 1024, 1, layer, wv_));
      PHASE(attn_phase(p, smem, j2, layer >= 2 ? 1024 : 1088, wv_);
            run_gemm<EPI_S5_S>(p, smem, p.XH, 512, p.Wst + (size_t)j2 * 32 * 65536, 256, 4352, 256, 256, 32, layer, wv_));
      PHASE(scan_phase(p, j2, wv_);
            if (layer == 0) setup_phase(p, smem, SETUP_B_END, SETUP_C_END, wv_));
      PHASE(if (layer == 0) run_gemm<EPI_MERGE>(p, smem, p.WuO, 1024, p.Wpool, 256, 1024, 1024, 256, 2, 0, wv_);
            run_gemm<EPI_S5_Y>(p, smem, p.XH, 512, p.W2 + (size_t)j2 * 32 * 131072, 512, 4352, 256, 512, 32, layer, wv_));
      PHASE(if (layer == 0) bias_phase(p, smem, 1, wv_);
            run_gemm<EPI_GLU>(p, smem, p.bbuf, 512, p.Wglu + (size_t)j2 * 512 * 512, 512, Mout, 512, 512, 1, layer, wv_));
    } else {
      PHASE(run_gemm<EPI_BF16>(p, smem, Ain, DM, p.WinO + (size_t)j2 * 2048 * 1024, 1024, Mrows, 2048, 1024, 1, layer, wv_));
      PHASE(pool_phase(p, Mrows, j2, wv_));
    }
    {
      const bool even = (layer & 1) == 0;
      PHASE(run_gemm<EPI_RESID>(p, smem, even ? p.abuf : p.bbuf, DM, (even ? p.WoutE : p.WoutO) + (size_t)j2 * 1024 * 1024, 1024, Mout, 1024, 1024, 1, layer, wv_));
    }
  }
  LAST_PHASE(final_phase(p, wv_));
}
#define N_PHASES 21

extern "C" void kernel_launch(void* const* d_in, const int* in_sizes, int n_in, void* d_out, int out_size, void* d_ws,
                              size_t ws_size, hipStream_t stream) {
  static int grid_blocks = 0;
  if (!grid_blocks) {
    int dev = 0, cus = 0, per_cu = 0;
    hipGetDevice(&dev);
    hipDeviceGetAttribute(&cus, hipDeviceAttributeMultiprocessorCount, dev);
    hipFuncSetAttribute((const void*)fwd_megakernel, hipFuncAttributeMaxDynamicSharedMemorySize, LDS_BYTES);
    hipOccupancyMaxActiveBlocksPerMultiprocessor(&per_cu, (const void*)fwd_megakernel, NTHREADS, LDS_BYTES);
    if (per_cu < 1) per_cu = 1;
    if (per_cu > 1) per_cu = 1;
    grid_blocks = (cus * per_cu) & ~7;
    if (grid_blocks < 8) grid_blocks = 8;
    fprintf(stderr, "kernel_launch: cus=%d per_cu=%d grid=%d ws=%zu\n", cus, per_cu, grid_blocks, ws_size);
  }
  P p{};
  const float* const* in = (const float* const*)d_in;
  p.x = in[0]; p.c = in[1]; p.ctx = in[2]; p.c_ctx = in[3]; p.ada_w = in[4]; p.ada_b = in[5]; p.norm_g = in[6];
  p.even_w_in = in[7]; p.even_w_out = in[8]; p.attn_sink = in[9]; p.a_re = in[10]; p.a_im = in[11]; p.log_dt = in[12];
  p.b_re = in[13]; p.b_im = in[14]; p.c_re = in[15]; p.c_im = in[16]; p.ssm_d = in[17]; p.glu_w = in[18]; p.glu_b = in[19];
  p.odd_w_in = in[20]; p.odd_w_out = in[21]; p.pool_w = in[22]; p.pool_scale = in[23]; p.final_g = in[24];
  p.out = (float*)d_out;
  char* ws = (char*)d_ws;
  size_t off = 0;
  auto take = [&](size_t bytes) { char* r = ws + off; off += (bytes + 255) & ~(size_t)255; return r; };
  p.mod = (float*)take((size_t)4 * 17 * 3072 * 4);
  p.rope = (float*)take(1024 * 2 * 4);
  p.aT = (float*)take((size_t)64 * 2 * 128 * 4);
  p.klag = (float*)take((size_t)64 * 8192 * 4);
  p.WinE = (bf16_t*)take((size_t)2 * 2304 * 1024 * 2);
  p.WoutE = (bf16_t*)take((size_t)2 * 1024 * 1024 * 2);
  p.Wglu = (bf16_t*)take((size_t)2 * 512 * 512 * 2);
  p.WinO = (bf16_t*)take((size_t)2 * 2048 * 1024 * 2);
  p.WoutO = (bf16_t*)take((size_t)2 * 1024 * 1024 * 2);
  p.Wpool = (bf16_t*)take((size_t)2 * 1024 * 256 * 2);
  p.Wst = (bf16_t*)take((size_t)64 * 65536 * 2);
  p.W2 = (bf16_t*)take((size_t)64 * 131072 * 2);
  p.hctx = (float*)take((size_t)4096 * 1024 * 4);
  p.abuf = (bf16_t*)take((size_t)MALL * 1024 * 2);
  p.bbuf = (bf16_t*)take((size_t)MALL * 1024 * 2);
  p.Sbuf = (float*)p.bbuf;
  p.proj = (bf16_t*)take((size_t)MALL * 2304 * 2);
  p.XH = (bf16_t*)take((size_t)32 * 4352 * 512 * 2);
  p.WuO = (bf16_t*)take((size_t)2 * 1024 * 1024 * 2);
  p.bar = (unsigned*)take(4096);
  p.rowss = (float*)take((size_t)4 * MALL * 4);
  p.bias = (float*)take((size_t)4 * 17 * 2304 * 4);
  if (off > ws_size) { fprintf(stderr, "kernel_launch: workspace too small: need %zu have %zu\n", off, ws_size); return; }
#ifdef MULTI_LAUNCH
  for (int k = 0; k < N_PHASES; ++k) {
    p.ph_lo = k; p.ph_hi = k + 1;
    hipLaunchKernelGGL(fwd_megakernel, dim3(grid_blocks), dim3(NTHREADS), LDS_BYTES, stream, p);
  }
#else
  p.ph_lo = 0; p.ph_hi = N_PHASES;
  hipMemsetAsync(p.bar, 0, 4096, stream);
  void* args[] = {&p};
  hipError_t e = hipLaunchCooperativeKernel((const void*)fwd_megakernel, dim3(grid_blocks), dim3(NTHREADS), args, LDS_BYTES, stream);
  if (e != hipSuccess) fprintf(stderr, "cooperative launch failed: %s (grid %d)\n", hipGetErrorString(e), grid_blocks);
#endif
}
```

```cpp
#ifndef DUP_PHASE
#define DUP_PHASE (-1)
#endif
#include <hip/hip_runtime.h>
#include <hip/hip_cooperative_groups.h>
#include <cstdio>
#include <cstdint>
namespace cg = cooperative_groups;

typedef unsigned short bf16_t;
typedef short bf16x8 __attribute__((ext_vector_type(8)));
typedef float f32x4 __attribute__((ext_vector_type(4)));
typedef unsigned u32x4 __attribute__((ext_vector_type(4)));

#define NLAT 65536
#define MALL 69632
#define DM 1024
#define LDO 2304
#define LDP 2304
#define LDS_BYTES 147456
#define NTHREADS 512
#define NWAVES 8

struct P {
  const float *x, *c, *ctx, *c_ctx, *ada_w, *ada_b, *norm_g, *even_w_in, *even_w_out, *attn_sink,
      *a_re, *a_im, *log_dt, *b_re, *b_im, *c_re, *c_im, *ssm_d, *glu_w, *glu_b, *odd_w_in, *odd_w_out,
      *pool_w, *pool_scale, *final_g;
  float* out;
  float *mod, *rope, *hctx, *aT, *klag, *Sbuf, *rowss, *bias;
  bf16_t *WinE, *WoutE, *Wglu, *WinO, *WoutO, *Wpool, *Wst, *W2, *abuf, *bbuf, *proj, *XH, *WuO;
  unsigned* bar;
  int ph_lo, ph_hi;
};

__device__ __forceinline__ bf16_t f2bf(float f) {
  unsigned u = __float_as_uint(f);
  u += 0x7fffu + ((u >> 16) & 1u);
  return (bf16_t)(u >> 16);
}
__device__ __forceinline__ int lane_id_opaque() { int l; asm volatile("v_mbcnt_lo_u32_b32 %0, -1, 0\n\tv_mbcnt_hi_u32_b32 %0, -1, %0" : "=v"(l)); return l; }
__device__ __forceinline__ float shflx(float v, int mask, int lane) { return __int_as_float(__builtin_amdgcn_ds_bpermute((lane ^ mask) << 2, __float_as_int(v))); }
__device__ __forceinline__ float bf2f(bf16_t h) { return __uint_as_float(((unsigned)h) << 16); }
typedef __bf16 bf16x2_t __attribute__((ext_vector_type(2)));
typedef float f32x2_t __attribute__((ext_vector_type(2)));
__device__ __forceinline__ unsigned pack2(float a, float b) {
  f32x2_t v = {a, b};
  bf16x2_t r = __builtin_convertvector(v, bf16x2_t);
  return __builtin_bit_cast(unsigned, r);
}
__device__ __forceinline__ float sigmoidf_(float x) { return __builtin_amdgcn_rcpf(1.0f + __builtin_amdgcn_exp2f(-1.4426950408889634f * x)); }
__device__ __forceinline__ float siluf_(float x) { return x * sigmoidf_(x); }
__device__ __forceinline__ float geluf_(float x) {
  float u = 0.7978845608028654f * (x + 0.044715f * x * x * x);
  return x * sigmoidf_(2.0f * u);
}
__device__ __forceinline__ const float* hin_row(const P& p, int layer, int row) {
  if (layer == 0) return row < NLAT ? p.x + (size_t)row * DM : p.ctx + (size_t)(row - NLAT) * DM;
  return row < NLAT ? p.out + (size_t)row * DM : p.hctx + (size_t)(row - NLAT) * DM;
}
__device__ __forceinline__ float* hout_row(const P& p, int row) {
  return row < NLAT ? p.out + (size_t)row * DM : p.hctx + (size_t)(row - NLAT) * DM;
}

__device__ __forceinline__ void setup_mod_item(const P& p, char* smem, int item, const int wv_) {
  const int layer = item / 48, cgp = item % 48;
  float* s = (float*)smem;
  int tid = (wv_ * 64 + lane_id_opaque()); asm volatile("" : "+v"(tid));
  const int lane = tid & 63, w = tid >> 6;
  for (int idx = tid; idx < 17 * 1024; idx += NTHREADS) {
    int b = idx >> 10, k = idx & 1023;
    float v = (b < 16) ? p.c[b * 1024 + k] : p.c_ctx[k];
    s[idx] = siluf_(v);
  }
  __syncthreads();
  float acc[17];
#pragma unroll
  for (int b = 0; b < 17; ++b) acc[b] = 0.f;
  const int n = cgp * 64 + lane;
  const float* wp = p.ada_w + ((size_t)layer * 1024 + w * 128) * 3072 + n;
  const float* sp = s + w * 128;
#pragma unroll 4
  for (int k = 0; k < 128; ++k) {
    float wv = wp[(size_t)k * 3072];
#pragma unroll
    for (int b = 0; b < 17; ++b) acc[b] += sp[b * 1024 + k] * wv;
  }
  __syncthreads();
  float* red = (float*)smem;
#pragma unroll
  for (int b = 0; b < 17; ++b) red[(w * 17 + b) * 64 + lane] = acc[b];
  __syncthreads();
  for (int idx = tid; idx < 17 * 64; idx += NTHREADS) {
    int b = idx >> 6, ln = idx & 63;
    float v = 0.f;
#pragma unroll
    for (int ww = 0; ww < NWAVES; ++ww) v += red[(ww * 17 + b) * 64 + ln];
    int nn = cgp * 64 + ln;
    p.mod[((size_t)layer * 17 + b) * 3072 + nn] = v + p.ada_b[layer * 3072 + nn];
  }
  __syncthreads();
}

__device__ __forceinline__ void transpose_tile(char* smem, const float* src, bf16_t* dst, int K, int N, int tile, const int wv_) {
  float* t = (float*)smem;
  const int tilesN = N / 64;
  const int k0 = (tile / tilesN) * 64, n0 = (tile % tilesN) * 64;
  int tid = (wv_ * 64 + lane_id_opaque()); asm volatile("" : "+v"(tid));
  const int tk = tid >> 6, tn = tid & 63;
#pragma unroll
  for (int r = 0; r < 8; ++r) {
    int k = r * 8 + tk;
    t[k * 65 + tn] = src[(size_t)(k0 + k) * N + n0 + tn];
  }
  __syncthreads();
#pragma unroll
  for (int r = 0; r < 8; ++r) {
    int n = r * 8 + tk;
    dst[(size_t)(n0 + n) * K + k0 + tn] = f2bf(t[tn * 65 + n]);
  }
  __syncthreads();
}

__device__ __forceinline__ float2 cmul(float2 a, float2 b) { return make_float2(a.x * b.x - a.y * b.y, a.x * b.y + a.y * b.x); }

__device__ __forceinline__ void setup_s5_item(const P& p, char* smem, int item, const int wv_) {
  const int j = item >> 5, g = item & 31;
  int tid = (wv_ * 64 + lane_id_opaque()); asm volatile("" : "+v"(tid));
  float2* pw = (float2*)smem;
  float2* Bb = pw + 2 * 17 * 64;
  float2* Cc = Bb + 2 * 64 * 16;
  float* klag = p.klag + (size_t)item * 8192;
  for (int idx = tid; idx < 2 * 17 * 64; idx += NTHREADS) {
    int dir = idx / (17 * 64), r = idx % (17 * 64), n = r >> 6, pp = r & 63;
    int pi = ((j * 2 + dir) * 32 + g) * 64 + pp;
    float dt = expf(p.log_dt[(j * 2 + dir) * 32 + g]);
    float xr = p.a_re[pi] * dt * (float)n, xi = p.a_im[pi] * dt * (float)n;
    float e = expf(xr), sn, cs;
    sincosf(xi, &sn, &cs);
    pw[idx] = make_float2(e * cs, e * sn);
  }
  for (int idx = tid; idx < 2 * 64 * 16; idx += NTHREADS) {
    int dir = idx >> 10, r = idx & 1023, pp = r >> 4, cc = r & 15;
    int pi = ((j * 2 + dir) * 32 + g) * 64 + pp;
    float dt = expf(p.log_dt[(j * 2 + dir) * 32 + g]);
    float lr = p.a_re[pi], li = p.a_im[pi];
    float xr = lr * dt, xi = li * dt;
    float sn, cs, sh, ch;
    sincosf(xi, &sn, &cs);
    sincosf(0.5f * xi, &sh, &ch);
    float em1 = expm1f(xr);
    float nr = em1 * cs - 2.0f * sh * sh, ni = (em1 + 1.0f) * sn;
    float den = lr * lr + li * li;
    float2 coef = make_float2((nr * lr + ni * li) / den, (ni * lr - nr * li) / den);
    size_t bi = (size_t)pi * 16 + cc;
    Bb[idx] = cmul(coef, make_float2(p.b_re[bi], p.b_im[bi]));
  }
  for (int idx = tid; idx < 2 * 16 * 64; idx += NTHREADS) {
    int dir = idx >> 10, r = idx & 1023, cc = r >> 6, pp = r & 63;
    size_t ci = ((size_t)((j * 2 + dir) * 32 + g) * 16 + cc) * 64 + pp;
    Cc[idx] = make_float2(p.c_re[ci], p.c_im[ci]);
  }
  __syncthreads();
  for (int idx = tid; idx < 8192; idx += NTHREADS) {
    int dir = idx >> 12, d = (idx >> 8) & 15, co = (idx >> 4) & 15, ci = idx & 15;
    float acc = 0.f;
    for (int pp = 0; pp < 64; ++pp) {
      float2 q = cmul(Cc[(dir * 16 + co) * 64 + pp], pw[(dir * 17 + d) * 64 + pp]);
      float2 bb = Bb[(dir * 64 + pp) * 16 + ci];
      acc += q.x * bb.x - q.y * bb.y;
    }
    klag[idx] = acc;
  }
  bf16_t* Wst = p.Wst + (size_t)item * 65536;
  for (int idx = tid; idx < 65536; idx += NTHREADS) {
    int n = idx >> 8, k = idx & 255;
    int dir = n >> 7, ri = (n >> 6) & 1, pp = n & 63, sg = k >> 4, cc = k & 15;
    int e = dir == 0 ? 15 - sg : sg;
    float2 v = cmul(pw[(dir * 17 + e) * 64 + pp], Bb[(dir * 64 + pp) * 16 + cc]);
    Wst[idx] = f2bf(ri == 0 ? v.x : v.y);
  }
  if (tid < 128) {
    int dir = tid >> 6, pp = tid & 63;
    float2 v = pw[(dir * 17 + 16) * 64 + pp];
    p.aT[((size_t)item * 2 + dir) * 128 + pp * 2] = v.x;
    p.aT[((size_t)item * 2 + dir) * 128 + pp * 2 + 1] = v.y;
  }
  __syncthreads();
  bf16_t* W2 = p.W2 + (size_t)item * 131072;
  for (int idx = tid; idx < 131072; idx += NTHREADS) {
    int n = idx >> 9, k = idx & 511;
    int tau = n >> 4, co = n & 15;
    float val;
    if (k < 256) {
      int sg = k >> 4, ci = k & 15;
      if (sg < tau) val = klag[((0 * 16 + (tau - sg)) * 16 + co) * 16 + ci];
      else if (sg > tau) val = klag[((1 * 16 + (sg - tau)) * 16 + co) * 16 + ci];
      else val = klag[((0 * 16 + 0) * 16 + co) * 16 + ci] + klag[((1 * 16 + 0) * 16 + co) * 16 + ci];
    } else {
      int kk = k - 256, dir = kk >> 7, ri = (kk >> 6) & 1, pp = kk & 63;
      int e = dir == 0 ? tau + 1 : 16 - tau;
      float2 q = cmul(Cc[(dir * 16 + co) * 64 + pp], pw[(dir * 17 + e) * 64 + pp]);
      val = ri == 0 ? q.x : -q.y;
    }
    W2[idx] = f2bf(val);
  }
  __syncthreads();
}

#define N_MOD_ITEMS 192
#define N_S5_ITEMS 64
#define T_WINE 1152
#define T_WOUTE 512
#define T_WGLU 128
#define T_WINO 512
#define T_WOUTO 512
#define T_POOL 128
#define N_CONV 256
#define N_TR_ITEMS (T_WINE + T_WOUTE + T_WGLU + T_WINO + T_WOUTO + T_POOL + N_CONV)
#define SETUP_A_END (N_MOD_ITEMS + N_S5_ITEMS + T_WINE + 1)
#define SETUP_B_END (SETUP_A_END + T_WOUTE + T_WGLU)
#define SETUP_C_END (SETUP_B_END + T_WINO + T_WOUTO + T_POOL + N_CONV)

__device__ __forceinline__ void bias_item(const P& p, char* smem, int layer, int nblk, const int wv_) {
  int tid = (wv_ * 64 + lane_id_opaque()); asm volatile("" : "+v"(tid));
  const int lane = tid & 63, w = tid >> 6;
  float* sh = (float*)smem;
  for (int idx = tid; idx < 17 * 1024; idx += NTHREADS) sh[idx] = p.mod[((size_t)layer * 17 + (idx >> 10)) * 3072 + (idx & 1023)];
  __syncthreads();
  const int j2 = layer >> 1;
  const bf16_t* Wt = (layer & 1) ? p.WinO + (size_t)j2 * 2048 * 1024 : p.WinE + (size_t)j2 * 2304 * 1024;
  const int n = nblk * 64 + lane;
  const bf16_t* wr = Wt + (size_t)n * 1024 + w * 128;
  float acc[17];
#pragma unroll
  for (int b = 0; b < 17; ++b) acc[b] = 0.f;
  for (int kc = 0; kc < 16; ++kc) {
    const uint4 wv4 = *(const uint4*)(wr + kc * 8);
    const unsigned ww[4] = {wv4.x, wv4.y, wv4.z, wv4.w};
    float wf[8];
#pragma unroll
    for (int e = 0; e < 4; ++e) { wf[2 * e] = bf2f((bf16_t)(ww[e] & 0xffff)); wf[2 * e + 1] = bf2f((bf16_t)(ww[e] >> 16)); }
    const float* sp = sh + w * 128 + kc * 8;
#pragma unroll
    for (int b = 0; b < 17; ++b)
#pragma unroll
      for (int e = 0; e < 8; ++e) acc[b] += sp[b * 1024 + e] * wf[e];
  }
  __syncthreads();
  float* red = (float*)smem;
#pragma unroll
  for (int b = 0; b < 17; ++b) red[(w * 17 + b) * 64 + lane] = acc[b];
  __syncthreads();
  for (int idx = tid; idx < 17 * 64; idx += NTHREADS) {
    int b = idx >> 6, ln = idx & 63;
    float v = 0.f;
#pragma unroll
    for (int ww2 = 0; ww2 < NWAVES; ++ww2) v += red[(ww2 * 17 + b) * 64 + ln];
    p.bias[((size_t)layer * 17 + b) * 2304 + nblk * 64 + ln] = v;
  }
  __syncthreads();
}
__device__ __forceinline__ void bias_phase(const P& p, char* smem, int which, const int wv_) {
  const int nitems = which == 0 ? 36 : 64;
  for (int it = blockIdx.x; it < nitems; it += gridDim.x) {
    if (which == 0) bias_item(p, smem, 2, it, wv_);
    else bias_item(p, smem, it < 32 ? 1 : 3, it & 31, wv_);
  }
}

__device__ __forceinline__ void setup_phase(const P& p, char* smem, int item_lo, int item_hi, const int wv_) {
  if (item_lo == 0) {
    int tz = (wv_ * 64 + lane_id_opaque()); asm volatile("" : "+v"(tz));
    for (int i = blockIdx.x * NTHREADS + tz; i < 4 * MALL; i += gridDim.x * NTHREADS) p.rowss[i] = 0.f;
  }
  for (int item = item_lo + blockIdx.x; item < item_hi; item += gridDim.x) {
    int it = item;
    if (it < N_MOD_ITEMS) { setup_mod_item(p, smem, it, wv_); continue; }
    it -= N_MOD_ITEMS;
    if (it < N_S5_ITEMS) { setup_s5_item(p, smem, it, wv_); continue; }
    it -= N_S5_ITEMS;
    if (it < T_WINE) { int j = it / 576, t = it % 576; transpose_tile(smem, p.even_w_in + (size_t)j * 1024 * 2304, p.WinE + (size_t)j * 2304 * 1024, 1024, 2304, t, wv_); continue; }
    it -= T_WINE;
    if (it < 1) {
      int tid_ = (wv_ * 64 + lane_id_opaque()); asm volatile("" : "+v"(tid_));
      for (int idx = tid_; idx < 1024; idx += NTHREADS) {
        int pos = idx >> 4, f = idx & 15;
        float inv = powf(10000.0f, -(float)f / 16.0f);
        float ang = (float)pos * inv;
        float sn, cs;
        sincosf(ang, &sn, &cs);
        p.rope[idx * 2] = cs;
        p.rope[idx * 2 + 1] = sn;
      }
      continue;
    }
    it -= 1;
    if (it < T_WOUTE) { int j = it / 256, t = it % 256; transpose_tile(smem, p.even_w_out + (size_t)j * 1024 * 1024, p.WoutE + (size_t)j * 1024 * 1024, 1024, 1024, t, wv_); continue; }
    it -= T_WOUTE;
    if (it < T_WGLU) { int j = it / 64, t = it % 64; transpose_tile(smem, p.glu_w + (size_t)j * 512 * 512, p.Wglu + (size_t)j * 512 * 512, 512, 512, t, wv_); continue; }
    it -= T_WGLU;
    if (it < T_WINO) { int j = it / 256, t = it % 256; transpose_tile(smem, p.odd_w_in + (size_t)j * 1024 * 2048, p.WinO + (size_t)j * 2048 * 1024, 1024, 2048, (t >> 4) * 32 + 16 + (t & 15), wv_); continue; }
    it -= T_WINO;
    if (it < T_WOUTO) { int j = it / 256, t = it % 256; transpose_tile(smem, p.odd_w_out + (size_t)j * 1024 * 1024, p.WoutO + (size_t)j * 1024 * 1024, 1024, 1024, t, wv_); continue; }
    it -= T_WOUTO;
    if (it < T_POOL) { int jg = it / 16, t = it % 16; transpose_tile(smem, p.pool_w + (size_t)jg * 65536, p.Wpool + (size_t)jg * 65536, 256, 256, t, wv_); continue; }
    it -= T_POOL;
    if (it < N_CONV) {
      const int j = it >> 7, r0 = (it & 127) * 8;
      int tid_ = (wv_ * 64 + lane_id_opaque()); asm volatile("" : "+v"(tid_));
      for (int e = tid_; e < 8 * 256; e += NTHREADS) {
        const int r = r0 + (e >> 8), c4 = (e & 255) * 4;
        const float4 v = *(const float4*)(p.odd_w_in + ((size_t)j * 1024 + r) * 2048 + c4);
        uint2 u; u.x = pack2(v.x, v.y); u.y = pack2(v.z, v.w);
        *(uint2*)(p.WuO + ((size_t)j * 1024 + r) * 1024 + c4) = u;
      }
      continue;
    }
  }
}

__device__ __forceinline__ void norm_phase(const P& p, int layer, int Mrows, const int wv_) {
  int tid_ = (wv_ * 64 + lane_id_opaque()); asm volatile("" : "+v"(tid_));
  const int lane = tid_ & 63, w = tid_ >> 6;
  const float* g = p.norm_g + layer * 1024;
  for (int row0 = (blockIdx.x * NWAVES + w) * 2; row0 < Mrows; row0 += gridDim.x * NWAVES * 2) {
    float4 v[2][4];
    float ss[2] = {0.f, 0.f};
#pragma unroll
    for (int r = 0; r < 2; ++r) {
      const float* src = hin_row(p, layer, row0 + r);
#pragma unroll
      for (int i = 0; i < 4; ++i) v[r][i] = *(const float4*)(src + i * 256 + lane * 4);
    }
#pragma unroll
    for (int r = 0; r < 2; ++r)
#pragma unroll
      for (int i = 0; i < 4; ++i) ss[r] += v[r][i].x * v[r][i].x + v[r][i].y * v[r][i].y + v[r][i].z * v[r][i].z + v[r][i].w * v[r][i].w;
#pragma unroll
    for (int o = 32; o; o >>= 1) { ss[0] += shflx(ss[0], o, lane); ss[1] += shflx(ss[1], o, lane); }
#pragma unroll
    for (int r = 0; r < 2; ++r) {
      const int row = row0 + r;
      const float rstd = rsqrtf(ss[r] * (1.0f / 1024.0f) + 1e-6f);
      const int b = row < NLAT ? (row >> 12) : 16;
      const float* md = p.mod + ((size_t)layer * 17 + b) * 3072;
      bf16_t* dst = p.abuf + (size_t)row * DM;
#pragma unroll
      for (int i = 0; i < 4; ++i) {
        int col = i * 256 + lane * 4;
        float4 gg = *(const float4*)(g + col);
        float4 sh = *(const float4*)(md + col);
        float4 sc = *(const float4*)(md + 1024 + col);
        float a0 = v[r][i].x * rstd * gg.x * (1.0f + sc.x) + sh.x;
        float a1 = v[r][i].y * rstd * gg.y * (1.0f + sc.y) + sh.y;
        float a2 = v[r][i].z * rstd * gg.z * (1.0f + sc.z) + sh.z;
        float a3 = v[r][i].w * rstd * gg.w * (1.0f + sc.w) + sh.w;
        uint2 o2;
        o2.x = pack2(a0, a1);
        o2.y = pack2(a2, a3);
        *(uint2*)(dst + col) = o2;
      }
    }
  }
}

__device__ __forceinline__ void final_phase(const P& p, const int wv_) {
  int tid_ = (wv_ * 64 + lane_id_opaque()); asm volatile("" : "+v"(tid_));
  const int lane = tid_ & 63, w = tid_ >> 6;
  for (int row0 = (blockIdx.x * NWAVES + w) * 2; row0 < NLAT; row0 += gridDim.x * NWAVES * 2) {
    float4 v[2][4];
    float ss[2] = {0.f, 0.f};
#pragma unroll
    for (int r = 0; r < 2; ++r) {
      const float* src = p.out + (size_t)(row0 + r) * DM;
#pragma unroll
      for (int i = 0; i < 4; ++i) v[r][i] = *(const float4*)(src + i * 256 + lane * 4);
    }
#pragma unroll
    for (int r = 0; r < 2; ++r)
#pragma unroll
      for (int i = 0; i < 4; ++i) ss[r] += v[r][i].x * v[r][i].x + v[r][i].y * v[r][i].y + v[r][i].z * v[r][i].z + v[r][i].w * v[r][i].w;
#pragma unroll
    for (int o = 32; o; o >>= 1) { ss[0] += shflx(ss[0], o, lane); ss[1] += shflx(ss[1], o, lane); }
#pragma unroll
    for (int r = 0; r < 2; ++r) {
      float* dst = p.out + (size_t)(row0 + r) * DM;
      const float rstd = rsqrtf(ss[r] * (1.0f / 1024.0f) + 1e-6f);
#pragma unroll
      for (int i = 0; i < 4; ++i) {
        int col = i * 256 + lane * 4;
        float4 gg = *(const float4*)(p.final_g + col);
        float4 o4 = make_float4(v[r][i].x * rstd * gg.x, v[r][i].y * rstd * gg.y, v[r][i].z * rstd * gg.z, v[r][i].w * rstd * gg.w);
        *(float4*)(dst + col) = o4;
      }
    }
  }
}

enum { EPI_EVEN_IN = 0, EPI_BF16 = 1, EPI_S5_S = 2, EPI_S5_Y = 3, EPI_GLU = 4, EPI_POOL = 5, EPI_RESID = 6, EPI_MERGE = 7 };

template <int EPI>
__device__ __forceinline__ void epi_frag(const P& p, int layer, int bt, int row, int col, const f32x4 a) {
  const int j2 = layer >> 1;
  if (EPI == EPI_EVEN_IN) {
    uint2 u;
    u.x = pack2(a[0], a[1]);
    u.y = pack2(a[2], a[3]);
    if (col >= 1280 && col < 1792) {
      const int cu = col - 1280, g = cu >> 4, c = cu & 15;
      int b, i;
      if (row < NLAT) { b = row >> 12; i = 256 + (row & 4095); } else { b = (row - NLAT) >> 8; i = (row - NLAT) & 255; }
      const int kap = i >> 4, sg = i & 15;
      *(uint2*)(p.XH + ((size_t)(g * 4352 + b * 272 + kap)) * 512 + sg * 16 + c) = u;
    } else {
      *(uint2*)(p.proj + (size_t)row * LDP + col) = u;
    }
  } else if (EPI == EPI_BF16) {
    uint2 u; u.x = pack2(a[0], a[1]); u.y = pack2(a[2], a[3]);
    *(uint2*)(p.proj + (size_t)row * LDO + col) = u;
  } else if (EPI == EPI_S5_S) {
    { uint2 u; u.x = pack2(a[0], a[1]); u.y = pack2(a[2], a[3]);
      *(uint2*)((bf16_t*)p.Sbuf + ((size_t)bt * 4352 + row) * 256 + col) = u; }
  } else if (EPI == EPI_S5_Y) {
    const int b = row / 272, kap = row % 272, tau = col >> 4, co = col & 15;
    const int i = kap * 16 + tau;
    const int trow = i < 256 ? NLAT + b * 256 + i : b * 4096 + (i - 256);
    uint2 uu = *(const uint2*)(p.XH + ((size_t)bt * 4352 + row) * 512 + col);
    const float4 dd = *(const float4*)(p.ssm_d + j2 * 512 + bt * 16 + co);
    float y0 = a[0] + bf2f((bf16_t)(uu.x & 0xffff)) * dd.x;
    float y1 = a[1] + bf2f((bf16_t)(uu.x >> 16)) * dd.y;
    float y2 = a[2] + bf2f((bf16_t)(uu.y & 0xffff)) * dd.z;
    float y3 = a[3] + bf2f((bf16_t)(uu.y >> 16)) * dd.w;
    uint2 u; u.x = pack2(geluf_(y0), geluf_(y1)); u.y = pack2(geluf_(y2), geluf_(y3));
    *(uint2*)(p.bbuf + (size_t)trow * 512 + bt * 16 + co) = u;
  } else if (EPI == EPI_GLU) {
    uint2 zz = *(const uint2*)(p.bbuf + (size_t)row * 512 + col);
    uint2 gg = *(const uint2*)(p.proj + (size_t)row * LDP + 1792 + col);
    const float4 gb = *(const float4*)(p.glu_b + j2 * 512 + col);
    float r0 = bf2f((bf16_t)(zz.x & 0xffff)) * sigmoidf_(a[0] + gb.x) * siluf_(bf2f((bf16_t)(gg.x & 0xffff)));
    float r1 = bf2f((bf16_t)(zz.x >> 16)) * sigmoidf_(a[1] + gb.y) * siluf_(bf2f((bf16_t)(gg.x >> 16)));
    float r2 = bf2f((bf16_t)(zz.y & 0xffff)) * sigmoidf_(a[2] + gb.z) * siluf_(bf2f((bf16_t)(gg.y & 0xffff)));
    float r3 = bf2f((bf16_t)(zz.y >> 16)) * sigmoidf_(a[3] + gb.w) * siluf_(bf2f((bf16_t)(gg.y >> 16)));
    uint2 u; u.x = pack2(r0, r1); u.y = pack2(r2, r3);
    *(uint2*)(p.abuf + (size_t)row * DM + 512 + col) = u;
  } else if (EPI == EPI_POOL) {
    uint2 gg = *(const uint2*)(p.proj + (size_t)row * LDO + 1024 + col);
    const float4 ps = *(const float4*)(p.pool_scale + j2 * 1024 + col);
    float r0 = a[0] * ps.x * siluf_(bf2f((bf16_t)(gg.x & 0xffff)));
    float r1 = a[1] * ps.y * siluf_(bf2f((bf16_t)(gg.x >> 16)));
    float r2 = a[2] * ps.z * siluf_(bf2f((bf16_t)(gg.y & 0xffff)));
    float r3 = a[3] * ps.w * siluf_(bf2f((bf16_t)(gg.y >> 16)));
    uint2 u; u.x = pack2(r0, r1); u.y = pack2(r2, r3);
    *(uint2*)(p.bbuf + (size_t)row * DM + col) = u;
  } else if (EPI == EPI_MERGE) {
    bf16_t* d = p.WinO + ((size_t)bt * 2048 + col) * 1024 + row;
    d[0] = f2bf(a[0]); d[1024] = f2bf(a[1]); d[2048] = f2bf(a[2]); d[3072] = f2bf(a[3]);
  } else if (EPI == EPI_RESID) {
    const int b = row < NLAT ? (row >> 12) : 16;
    const float4 gt = *(const float4*)(p.mod + ((size_t)layer * 17 + b) * 3072 + 2048 + col);
    const float4 hv = *(const float4*)(hin_row(p, layer, row) + col);
    float4 o4 = make_float4(hv.x + gt.x * a[0], hv.y + gt.y * a[1], hv.z + gt.z * a[2], hv.w + gt.w * a[3]);
    *(float4*)(hout_row(p, row) + col) = o4;
  }
}

template <int EPI>
__device__ __forceinline__ void epi_pair(const P& p, int layer, int bt, int row, int col, int off2, int axis, int fq, const f32x4 a0, const f32x4 a1) {
  if (EPI == EPI_EVEN_IN) {
    if (col < 640 && row < NLAT) {
      const int t = row & 4095;
      const int pos = axis == 0 ? (t >> 6) : (t & 63);
      const float* tb = p.rope + (pos * 16 + fq * 4) * 2;
      const float4 cs0 = *(const float4*)(tb), cs1 = *(const float4*)(tb + 4);
      const float cs[4] = {cs0.x, cs0.z, cs1.x, cs1.z}, sn[4] = {cs0.y, cs0.w, cs1.y, cs1.w};
      float o1[4], o2[4];
#pragma unroll
      for (int jj = 0; jj < 4; ++jj) {
        o1[jj] = a0[jj] * cs[jj] - a1[jj] * sn[jj];
        o2[jj] = a1[jj] * cs[jj] + a0[jj] * sn[jj];
      }
      bf16_t* d1 = p.proj + (size_t)row * LDP + col;
      uint2 u1, u2;
      u1.x = pack2(o1[0], o1[1]); u1.y = pack2(o1[2], o1[3]);
      u2.x = pack2(o2[0], o2[1]); u2.y = pack2(o2[2], o2[3]);
      *(uint2*)d1 = u1;
      *(uint2*)(d1 + 16) = u2;
      return;
    }
  }
  epi_frag<EPI>(p, layer, bt, row, col, a0);
  epi_frag<EPI>(p, layer, bt, row, col + off2, a1);
}

namespace pg8 {
#define PG8_LAS __attribute__((address_space(3)))
constexpr int BM = 256, BK = 64, HALF = 128, HTB = HALF * BK * 2  , STAGE_BYTES = 8 * HTB;
__host__ __device__ __forceinline__ int lds_byte(int r, int c) { const int st = (r >> 4) * 2 + (c >> 5), rr = r & 15, cc = c & 31, ob = rr * 64 + cc * 2; return st * 1024 + (ob ^ (((ob >> 9) & 1) << 5)); }
__host__ __device__ __forceinline__ void stage_rc(int b, int& R, int& C) { const int st = b / 1024, sb = b % 1024, swz = sb ^ (((sb >> 9) & 1) << 5); R = (st >> 1) * 16 + swz / 64; C = (st & 1) * 32 + (swz % 64) / 2; }
__host__ __device__ __forceinline__ int perm32(int rho) { const int n = rho >> 4, i = rho & 15; return 8 * (i >> 2) + 4 * n + (i & 3); }
struct Unit { int pm, pn, pb, ka; };
struct Gemm { const bf16_t* A; const bf16_t* Bt; int lda, ldb, K; };
struct BandOrder {
    int tilesN, tilesMb, Rx, Tx, nxb, xcd, lb, pool;
    __device__ void init(int Rtot, int tilesN_, int tilesMb_, int pool_, int lbshift) { tilesN = tilesN_; tilesMb = tilesMb_; pool = pool_; nxb = gridDim.x >> 3; xcd = blockIdx.x & 7;
        lb = ((int)(blockIdx.x >> 3) + lbshift) % nxb;
        Rx = Rtot >> 3; Tx = Rx * tilesN; }
    __device__ bool next(int i, Unit& u) const {
        const int L = lb + i * nxb; if (L >= Tx) return false;
        const int rt = xcd * Rx + L / tilesN, nt = L % tilesN;
        u.pm = rt; u.pn = nt; u.pb = (rt / tilesMb) * tilesN + nt; u.ka = pool ? nt * 256 : 0; return true;
    }
    __device__ __forceinline__ void a_ready(const Unit&) const {}
    __device__ __forceinline__ void done(const Unit&) const {}
};
template <class Epi, class Sched, bool ALIGN_EPI = false, bool SP2 = false>
__device__ __forceinline__ void gemm_phase(PG8_LAS unsigned char* lds, const Gemm g, const Sched& S, const Epi& E, const int wv_) {
    int tid = (wv_ * 64 + lane_id_opaque()); asm volatile("" : "+v"(tid)); const int wid = __builtin_amdgcn_readfirstlane(tid >> 6), lane = tid & 63, wr = wid >> 2, wc = wid & 3, fr = lane & 15, fq = lane >> 4;
    const int K = g.K, nt = K / BK, lda = g.lda, ldb = g.ldb;
    unsigned voffA[2], voffB[2];
#pragma unroll
    for (int i = 0; i < 2; ++i) { int R, C; stage_rc(tid * 16 + i * 8192, R, C); const int Rb = Epi::PERM ? ((R & ~31) + perm32(R & 31)) : R;
        voffA[i] = (unsigned)(R * lda + C) * 2u; voffB[i] = (unsigned)(Rb * ldb + C) * 2u; }
    const size_t kstep = (size_t)(BK * 2);
    const size_t hstepA = (size_t)HALF * lda * 2, hstepB = (size_t)HALF * ldb * 2;
    const unsigned ldsw = (unsigned)wid * 1024u;
    const int aoff = lds_byte(wr * 64 + fr, fq * 8), boff = lds_byte(wc * 32 + fr, fq * 8);
#define PG8_SA(b, h) (((b) * 2 + (h)) * HTB)
#define PG8_SB(b, h) ((4 + (b) * 2 + (h)) * HTB)
#define PG8_STAGE(bufoff, gbase, voff) do { _Pragma("unroll") for (int _i = 0; _i < 2; ++_i) \
        __builtin_amdgcn_global_load_lds((const unsigned*)((const char*)(gbase) + (voff)[_i]), (PG8_LAS unsigned*)(lds + (bufoff) + ldsw + _i * 8192), 16, 0, 0); } while (0)
#define PG8_LDA(dst, b, h) do { _Pragma("unroll") for (int m = 0; m < 4; ++m) _Pragma("unroll") for (int k = 0; k < 2; ++k) dst[m][k] = *(const PG8_LAS bf16x8*)(lds + PG8_SA(b, h) + aoff + m * 2048 + k * 1024); } while (0)
#define PG8_LDB(dst, b, h) do { _Pragma("unroll") for (int n = 0; n < 2; ++n) _Pragma("unroll") for (int k = 0; k < 2; ++k) dst[n][k] = *(const PG8_LAS bf16x8*)(lds + PG8_SB(b, h) + boff + n * 2048 + k * 1024); } while (0)
#define PG8_MMA(ai, bj, At, Bt) do { __builtin_amdgcn_s_setprio(1); _Pragma("unroll") for (int m = 0; m < 4; ++m) _Pragma("unroll") for (int n = 0; n < 2; ++n) _Pragma("unroll") for (int k = 0; k < 2; ++k) \
        acc[ai][bj][m][n] = __builtin_amdgcn_mfma_f32_16x16x32_bf16(Bt[n][k], At[m][k], acc[ai][bj][m][n], 0, 0, 0); __builtin_amdgcn_s_setprio(0); } while (0)
#define PG8_WAIT_V(n) asm volatile("s_waitcnt vmcnt(" #n ")" ::: "memory")
#define PG8_WAIT_L(n) asm volatile("s_waitcnt lgkmcnt(" #n ")" ::: "memory")
#define PG8_BAR __builtin_amdgcn_s_barrier()
#define PG8_SCHED __builtin_amdgcn_sched_barrier(0)
    Unit cur, nxt; int ui = 0;
    if (!S.next(0, cur)) return;
    f32x4 acc[2][2][4][2];
#pragma unroll
    for (int a = 0; a < 2; ++a)
#pragma unroll
        for (int b = 0; b < 2; ++b)
#pragma unroll
            for (int m = 0; m < 4; ++m)
#pragma unroll
                for (int n = 0; n < 2; ++n) acc[a][b][m][n] = (f32x4){0.f, 0.f, 0.f, 0.f};
    bf16x8 At[4][2], B0[2][2], B1[2][2];
    const char* cA = (const char*)(g.A + (size_t)cur.pm * BM * lda + cur.ka); const char* cB = (const char*)(g.Bt + (size_t)cur.pb * BM * ldb);
    S.a_ready(cur);
    if constexpr (SP2) {
        PG8_STAGE(PG8_SB(0, 0), cB, voffB); PG8_STAGE(PG8_SB(0, 1), cB + hstepB, voffB); PG8_STAGE(PG8_SA(0, 0), cA, voffA); PG8_STAGE(PG8_SA(0, 1), cA + hstepA, voffA);
        if (wr == 1) PG8_BAR;
        PG8_WAIT_V(2); PG8_BAR;
        PG8_STAGE(PG8_SB(1, 0), cB + kstep, voffB); PG8_STAGE(PG8_SA(1, 0), cA + kstep, voffA); PG8_STAGE(PG8_SB(1, 1), cB + hstepB + kstep, voffB);
        PG8_WAIT_V(6); PG8_BAR;
    } else {
        PG8_STAGE(PG8_SB(0, 0), cB, voffB); PG8_STAGE(PG8_SA(0, 0), cA, voffA); PG8_STAGE(PG8_SB(0, 1), cB + hstepB, voffB); PG8_STAGE(PG8_SA(0, 1), cA + hstepA, voffA);
        if (wr == 1) PG8_BAR;
        PG8_WAIT_V(4); PG8_BAR;
        PG8_STAGE(PG8_SB(1, 0), cB + kstep, voffB); PG8_STAGE(PG8_SA(1, 0), cA + kstep, voffA); PG8_STAGE(PG8_SB(1, 1), cB + hstepB + kstep, voffB);
        PG8_WAIT_V(6); PG8_BAR;
    }
    for (;;) {
        const bool has_next = S.next(ui + 1, nxt);
        const char* nA = has_next ? (const char*)(g.A + (size_t)nxt.pm * BM * lda + nxt.ka) : cA; const char* nB = has_next ? (const char*)(g.Bt + (size_t)nxt.pb * BM * ldb) : cB;
        for (int t = 0; t < nt; t += 2) {
            const bool last = (t == nt - 2);
            const char* a1 = cA + (size_t)(t + 1) * kstep;
            const char* a2 = last ? nA : cA + (size_t)(t + 2) * kstep; const char* b2 = last ? nB : cB + (size_t)(t + 2) * kstep;
            const char* a3 = a2 + kstep; const char* b3 = b2 + kstep;
            if (last && has_next) S.a_ready(nxt);
            if constexpr (SP2) {
            PG8_LDB(B0, 0, 0); PG8_LDB(B1, 0, 1); PG8_SCHED; PG8_LDA(At, 0, 0); PG8_STAGE(PG8_SA(1, 1), a1 + hstepA, voffA);
            PG8_WAIT_V(8); PG8_WAIT_L(0); PG8_BAR; PG8_MMA(0, 0, At, B0); PG8_MMA(0, 1, At, B1); PG8_BAR; PG8_SCHED;
            PG8_LDA(At, 0, 1); PG8_STAGE(PG8_SB(0, 0), b2, voffB); PG8_STAGE(PG8_SB(0, 1), b2 + hstepB, voffB); PG8_STAGE(PG8_SA(0, 0), a2, voffA);
            PG8_WAIT_V(8); PG8_WAIT_L(0); PG8_BAR; PG8_MMA(1, 0, At, B0); PG8_MMA(1, 1, At, B1); PG8_BAR; PG8_SCHED;
            PG8_LDB(B0, 1, 0); PG8_LDB(B1, 1, 1); PG8_SCHED; PG8_LDA(At, 1, 0); PG8_STAGE(PG8_SA(0, 1), a2 + hstepA, voffA);
            PG8_WAIT_V(8); PG8_WAIT_L(0); PG8_BAR; PG8_MMA(0, 0, At, B0); PG8_MMA(0, 1, At, B1); PG8_BAR; PG8_SCHED;
            PG8_LDA(At, 1, 1); PG8_STAGE(PG8_SB(1, 0), b3, voffB); PG8_STAGE(PG8_SB(1, 1), b3 + hstepB, voffB); PG8_STAGE(PG8_SA(1, 0), a3, voffA);
            PG8_WAIT_V(8); PG8_WAIT_L(0); PG8_BAR; PG8_MMA(1, 0, At, B0); PG8_MMA(1, 1, At, B1); PG8_BAR; PG8_SCHED;
            } else {
            PG8_LDB(B0, 0, 0); PG8_SCHED; PG8_LDA(At, 0, 0); PG8_STAGE(PG8_SA(1, 1), a1 + hstepA, voffA);
            PG8_WAIT_L(8); PG8_BAR; PG8_WAIT_L(0); PG8_MMA(0, 0, At, B0); PG8_BAR; PG8_SCHED;
            PG8_LDB(B1, 0, 1); PG8_STAGE(PG8_SB(0, 0), b2, voffB);
            PG8_BAR; PG8_WAIT_L(0); PG8_MMA(0, 1, At, B1); PG8_BAR;
            PG8_LDA(At, 0, 1); PG8_STAGE(PG8_SA(0, 0), a2, voffA);
            PG8_BAR; PG8_WAIT_L(0); PG8_MMA(1, 0, At, B0); PG8_BAR; PG8_SCHED;
            PG8_STAGE(PG8_SB(0, 1), b2 + hstepB, voffB);
            PG8_WAIT_V(6); PG8_BAR; PG8_MMA(1, 1, At, B1); PG8_BAR;
            PG8_LDB(B0, 1, 0); PG8_SCHED; PG8_LDA(At, 1, 0); PG8_STAGE(PG8_SA(0, 1), a2 + hstepA, voffA);
            PG8_WAIT_L(8); PG8_BAR; PG8_WAIT_L(0); PG8_MMA(0, 0, At, B0); PG8_BAR; PG8_SCHED;
            PG8_LDB(B1, 1, 1); PG8_STAGE(PG8_SB(1, 0), b3, voffB);
            PG8_BAR; PG8_WAIT_L(0); PG8_MMA(0, 1, At, B1); PG8_BAR;
            PG8_LDA(At, 1, 1); PG8_STAGE(PG8_SA(1, 0), a3, voffA);
            PG8_BAR; PG8_WAIT_L(0); PG8_MMA(1, 0, At, B0); PG8_BAR; PG8_SCHED;
            PG8_STAGE(PG8_SB(1, 1), b3 + hstepB, voffB);
            PG8_WAIT_V(6); PG8_BAR; PG8_MMA(1, 1, At, B1); PG8_BAR;
            }
        }
        if constexpr (ALIGN_EPI) { if (wr == 0) PG8_BAR; }
        if constexpr (!Epi::AFTER_DRAIN) { E(acc, cur, wr, wc, fr, fq); S.done(cur); }
        if (!has_next) break;
#pragma unroll
        for (int a = 0; a < 2; ++a)
#pragma unroll
            for (int b = 0; b < 2; ++b)
#pragma unroll
                for (int m = 0; m < 4; ++m)
#pragma unroll
                    for (int n = 0; n < 2; ++n) acc[a][b][m][n] = (f32x4){0.f, 0.f, 0.f, 0.f};
        cur = nxt; cA = nA; cB = nB; ++ui;
        if constexpr (ALIGN_EPI) { if (wr == 1) PG8_BAR; }
    }
    PG8_WAIT_V(0);
    if constexpr (!ALIGN_EPI) { if (wr == 0) PG8_BAR; }
    PG8_BAR;
    if constexpr (Epi::AFTER_DRAIN) { E.fused(acc, cur, wr, wc, fr, fq, lds, wid, lane); S.done(cur); }
#undef PG8_SA
#undef PG8_SB
#undef PG8_STAGE
#undef PG8_LDA
#undef PG8_LDB
#undef PG8_MMA
#undef PG8_WAIT_V
#undef PG8_WAIT_L
#undef PG8_BAR
#undef PG8_SCHED
}
}

template <int EPI> struct MyEpi {
    static constexpr bool PERM = (EPI == EPI_GLU || EPI == EPI_S5_Y || EPI == EPI_S5_S), AFTER_DRAIN = false;
    const P* pp; int layer, tilesMb;
    __device__ __forceinline__ void operator()(const f32x4 (&acc)[2][2][4][2], const pg8::Unit& u, int wr, int wc, int fr, int fq) const {
        const P& p = *pp;
        const int bt = u.pm / tilesMb;
        const int rowt = (u.pm - bt * tilesMb) * 256;
#pragma unroll
        for (int ai = 0; ai < 2; ++ai)
#pragma unroll
            for (int m = 0; m < 4; ++m) {
                const int row = rowt + ai * 128 + wr * 64 + m * 16 + fr;
                float rstd = 1.0f;
                if ((EPI == EPI_EVEN_IN || EPI == EPI_BF16) && layer > 0) rstd = rsqrtf(p.rowss[(size_t)layer * MALL + row] * (1.0f / 1024.0f) + 1e-6f);
#pragma unroll
                for (int bj = 0; bj < 2; ++bj) {
                    const int col = u.pn * 256 + bj * 128 + wc * 32 + (PERM ? fq * 8 : fq * 4);
                    f32x4 a0 = acc[ai][bj][m][0], a1 = acc[ai][bj][m][1];
                    if ((EPI == EPI_EVEN_IN || EPI == EPI_BF16) && layer > 0) {
                        const float* bp = p.bias + ((size_t)layer * 17 + (rowt < NLAT ? (rowt >> 12) : 16)) * 2304 + col;
                        a0 = a0 * rstd + *(const f32x4*)(bp);
                        a1 = a1 * rstd + *(const f32x4*)(bp + 16);
                    }
                    epi_pair<EPI>(p, layer, bt, row, col, PERM ? 4 : 16, wc & 1, fq, a0, a1);
                }
            }
    }
};

template <> struct MyEpi<EPI_EVEN_IN> {
    static constexpr bool PERM = true, AFTER_DRAIN = false;
    const P* pp; int layer, tilesMb;
    __device__ __forceinline__ void operator()(const f32x4 (&acc)[2][2][4][2], const pg8::Unit& u, int wr, int wc, int fr, int fq) const {
        const P& p = *pp;
        const int rowt = u.pm * 256;
        const int lane_ = fq * 16 + fr;
        const int col0 = u.pn * 256 + wc * 32 + fq * 8;
        const bool latent = rowt < NLAT;
        f32x4 bv[2][2];
        if (layer > 0) {
            const float* bp = p.bias + ((size_t)layer * 17 + (latent ? (rowt >> 12) : 16)) * 2304 + col0;
#pragma unroll
            for (int bj = 0; bj < 2; ++bj)
#pragma unroll
                for (int n = 0; n < 2; ++n) bv[bj][n] = *(const f32x4*)(bp + bj * 128 + n * 4);
        }
#pragma unroll
        for (int ai = 0; ai < 2; ++ai)
#pragma unroll
            for (int m = 0; m < 4; ++m) {
                const int row = rowt + ai * 128 + wr * 64 + m * 16 + fr;
                float rstd = 1.0f;
                if (layer > 0) rstd = rsqrtf(p.rowss[(size_t)layer * MALL + row] * (1.0f / 1024.0f) + 1e-6f);
#pragma unroll
                for (int bj = 0; bj < 2; ++bj) {
                    const int colb = col0 + bj * 128;
                    f32x4 v0 = acc[ai][bj][m][0], v1 = acc[ai][bj][m][1];
                    if (layer > 0) { v0 = v0 * rstd + bv[bj][0]; v1 = v1 * rstd + bv[bj][1]; }
                    if (colb < 640 && latent) {
                        const int t = row & 4095;
                        const int pos = (wc & 1) == 0 ? (t >> 6) : (t & 63);
                        const float* tb = p.rope + (pos * 16 + 8 * (fq & 1)) * 2;
                        const f32x4 t0 = *(const f32x4*)(tb), t1 = *(const f32x4*)(tb + 4), t2 = *(const f32x4*)(tb + 8), t3 = *(const f32x4*)(tb + 12);
                        const float cs[8] = {t0[0], t0[2], t1[0], t1[2], t2[0], t2[2], t3[0], t3[2]};
                        const float sn[8] = {t0[1], t0[3], t1[1], t1[3], t2[1], t2[3], t3[1], t3[3]};
                        const float sg = (fq >> 1) ? 1.0f : -1.0f;
                        float o[8];
#pragma unroll
                        for (int j = 0; j < 4; ++j) {
                            const float p0 = shflx(v0[j], 32, lane_), p1 = shflx(v1[j], 32, lane_);
                            o[j] = v0[j] * cs[j] + sg * p0 * sn[j];
                            o[4 + j] = v1[j] * cs[4 + j] + sg * p1 * sn[4 + j];
                        }
                        *(uint4*)(p.proj + (size_t)row * LDP + colb) = make_uint4(pack2(o[0], o[1]), pack2(o[2], o[3]), pack2(o[4], o[5]), pack2(o[6], o[7]));
                    } else {
                        const uint4 w4 = make_uint4(pack2(v0[0], v0[1]), pack2(v0[2], v0[3]), pack2(v1[0], v1[1]), pack2(v1[2], v1[3]));
                        if (colb >= 1280 && colb < 1792) {
                            const int cu = colb - 1280, g = cu >> 4, c = cu & 15;
                            int b, i;
                            if (latent) { b = row >> 12; i = 256 + (row & 4095); } else { b = (row - NLAT) >> 8; i = (row - NLAT) & 255; }
                            *(uint4*)(p.XH + ((size_t)(g * 4352 + b * 272 + (i >> 4))) * 512 + (i & 15) * 16 + c) = w4;
                        } else {
                            *(uint4*)(p.proj + (size_t)row * LDP + colb) = w4;
                        }
                    }
                }
            }
    }
};

template <> struct MyEpi<EPI_BF16> {
    static constexpr bool PERM = true, AFTER_DRAIN = false;
    const P* pp; int layer, tilesMb;
    __device__ __forceinline__ void operator()(const f32x4 (&acc)[2][2][4][2], const pg8::Unit& u, int wr, int wc, int fr, int fq) const {
        const P& p = *pp;
        const int rowt = u.pm * 256;
        const int col0 = u.pn * 256 + wc * 32 + fq * 8;
        const float* bp = p.bias + ((size_t)layer * 17 + (rowt < NLAT ? (rowt >> 12) : 16)) * 2304 + col0;
        f32x4 bv[2][2];
#pragma unroll
        for (int bj = 0; bj < 2; ++bj)
#pragma unroll
            for (int n = 0; n < 2; ++n) bv[bj][n] = *(const f32x4*)(bp + bj * 128 + n * 4);
#pragma unroll
        for (int ai = 0; ai < 2; ++ai)
#pragma unroll
            for (int m = 0; m < 4; ++m) {
                const int row = rowt + ai * 128 + wr * 64 + m * 16 + fr;
                const float rstd = rsqrtf(p.rowss[(size_t)layer * MALL + row] * (1.0f / 1024.0f) + 1e-6f);
#pragma unroll
                for (int bj = 0; bj < 2; ++bj) {
                    const f32x4 v0 = acc[ai][bj][m][0] * rstd + bv[bj][0], v1 = acc[ai][bj][m][1] * rstd + bv[bj][1];
                    uint4 w4 = make_uint4(pack2(v0[0], v0[1]), pack2(v0[2], v0[3]), pack2(v1[0], v1[1]), pack2(v1[2], v1[3]));
                    *(uint4*)(p.proj + (size_t)row * LDO + col0 + bj * 128) = w4;
                }
            }
    }
};

template <> struct MyEpi<EPI_RESID> {
    static constexpr bool PERM = true, AFTER_DRAIN = false;
    const P* pp; int layer, tilesMb;
    __device__ __forceinline__ void operator()(const f32x4 (&acc)[2][2][4][2], const pg8::Unit& u, int wr, int wc, int fr, int fq) const {
        const P& p = *pp;
        const int rowt = u.pm * 256;
        const int b = rowt < NLAT ? (rowt >> 12) : 16;
        const float* hin = hin_row(p, layer, rowt);
        float* hout = hout_row(p, rowt);
        const int col0 = u.pn * 256 + wc * 32 + fq * 8;
        const float* gp = p.mod + ((size_t)layer * 17 + b) * 3072 + 2048 + col0;
        f32x4 gt[2][2], gm[2][2];
        const int lane_ = fq * 16 + fr;
        const int ln = layer < 3 ? layer + 1 : 3;
        bf16_t* hb = ((layer & 1) ? p.abuf : p.bbuf) + (size_t)rowt * DM;
#pragma unroll
        for (int bj = 0; bj < 2; ++bj)
#pragma unroll
            for (int n = 0; n < 2; ++n) {
                gt[bj][n] = *(const f32x4*)(gp + bj * 128 + n * 4);
                const f32x4 ng = *(const f32x4*)(p.norm_g + ln * 1024 + col0 + bj * 128 + n * 4);
                const f32x4 sc = *(const f32x4*)(p.mod + ((size_t)ln * 17 + b) * 3072 + 1024 + col0 + bj * 128 + n * 4);
                gm[bj][n] = ng * (sc + 1.0f);
            }
#pragma unroll
        for (int ai = 0; ai < 2; ++ai)
#pragma unroll
            for (int m = 0; m < 4; ++m) {
                f32x4 hv[2][2];
                float rs = 0.f;
                const int rloc = ai * 128 + wr * 64 + m * 16 + fr;
                const size_t ro = (size_t)rloc * DM + col0;
#pragma unroll
                for (int bj = 0; bj < 2; ++bj)
#pragma unroll
                    for (int n = 0; n < 2; ++n) hv[bj][n] = *(const f32x4*)(hin + ro + bj * 128 + n * 4);
#pragma unroll
                for (int bj = 0; bj < 2; ++bj)
#pragma unroll
                    for (int n = 0; n < 2; ++n) {
                        const f32x4 o = hv[bj][n] + gt[bj][n] * acc[ai][bj][m][n];
                        *(f32x4*)(hout + ro + bj * 128 + n * 4) = o;
                        if (layer < 3) {
                            const f32x4 q = o * gm[bj][n];
                            uint2 w2; w2.x = pack2(q[0], q[1]); w2.y = pack2(q[2], q[3]);
                            *(uint2*)(hb + ro + bj * 128 + n * 4) = w2;
                            rs += o[0] * o[0] + o[1] * o[1] + o[2] * o[2] + o[3] * o[3];
                        }
                    }
                if (layer < 3) {
                    rs += shflx(rs, 16, lane_); rs += shflx(rs, 32, lane_);
                    if (fq == 0) atomicAdd(p.rowss + (size_t)(layer + 1) * MALL + rowt + rloc, rs);
                }
            }
    }
};

template <int EPI>
__device__ __forceinline__ void run_gemm(const P& p, char* smem, const bf16_t* A, int lda, const bf16_t* Bt, int ldb, int Mrows, int N, int K, int nbatch, int layer, const int wv_) {
    pg8::Gemm g; g.A = A; g.Bt = Bt; g.lda = lda; g.ldb = ldb; g.K = K;
    pg8::BandOrder S; S.init(nbatch * (Mrows >> 8), N >> 8, Mrows >> 8, (EPI == EPI_POOL || EPI == EPI_MERGE) ? 1 : 0, (EPI == EPI_S5_S || EPI == EPI_S5_Y || EPI == EPI_GLU) ? 16 : 0);
    MyEpi<EPI> E; E.pp = &p; E.layer = layer; E.tilesMb = Mrows >> 8;
    pg8::gemm_phase<MyEpi<EPI>, pg8::BandOrder, true, true>((PG8_LAS unsigned char*)smem, g, S, E, wv_);
    __syncthreads();
}

__device__ __forceinline__ void attn_phase(const P& p, char* smem, int j2, int nunits, const int wv_) {
  const bf16_t* proj = p.proj;
  const float SC = 0.125f * 1.4426950408889634f;
  for (int unit = blockIdx.x; unit < nunits; unit += gridDim.x) {
    int tid = (wv_ * 64 + lane_id_opaque()); asm volatile("" : "+v"(tid));
    const int lane = tid & 63, w = __builtin_amdgcn_readfirstlane(tid >> 6), lr = lane & 15, lq = lane >> 4;
    const int hk = w >> 2, wl = w & 3, tl = tid & 255;
    int b, qb, qpos0, nloc, ilo;
    size_t qrow0;
    if (unit < 1024) {
      b = unit >> 6; qb = unit & 63;
      qrow0 = (size_t)b * 4096 + qb * 64; qpos0 = qb * 64;
      ilo = 2 - qb; if (ilo < 0) ilo = 0;
      int ihi = 65 - qb; if (ihi > 4) ihi = 4;
      nloc = ihi - ilo + 1;
    } else {
      int u = unit - 1024;
      b = u >> 2; qb = u & 3;
      qrow0 = (size_t)NLAT + b * 256 + qb * 64; qpos0 = 0; nloc = 0; ilo = 0;
    }
    const int h = w;
    const int ntl = 4 + nloc;
    char* sQ = smem + 73728 + w * 9216;
#pragma unroll 1
    for (int i = 0; i < 8; ++i) {
      int c = lane + 64 * i;
      *(uint4*)(sQ + (c >> 3) * 144 + (c & 7) * 16) = *(const uint4*)(proj + (qrow0 + (c >> 3)) * LDP + h * 64 + (c & 7) * 8);
    }
    f32x4 o[4][4];
    float mrun[4], lrun[4];
#pragma unroll
    for (int qi = 0; qi < 4; ++qi) {
      mrun[qi] = -1e30f; lrun[qi] = 0.f;
#pragma unroll
      for (int dt = 0; dt < 4; ++dt) o[qi][dt] = (f32x4){0.f, 0.f, 0.f, 0.f};
    }
    uint4 rk0, rk1, rv0, rv1;
#define TILE_ROW(t, kstart, krow) do { if ((t) < 4) { kstart = -100000; krow = (size_t)NLAT + b * 256 + (t) * 64; } else { kstart = qpos0 - 128 + 64 * (ilo + (t) - 4); krow = (size_t)b * 4096 + kstart; } } while (0)
#define LOAD_TILE_K(krow) do { \
      rk0 = *(const uint4*)(proj + ((krow) + (tl >> 3)) * LDP + 512 + hk * 64 + (tl & 7) * 8); \
      rk1 = *(const uint4*)(proj + ((krow) + 32 + (tl >> 3)) * LDP + 512 + hk * 64 + (tl & 7) * 8); } while (0)
#define LOAD_TILE_V(krow) do { \
      rv0 = *(const uint4*)(proj + ((krow) + lane) * LDP + 640 + hk * 64 + wl * 8); \
      rv1 = *(const uint4*)(proj + ((krow) + lane) * LDP + 640 + hk * 64 + (wl + 4) * 8); } while (0)
#define LOAD_TILE(krow) do { LOAD_TILE_K(krow); LOAD_TILE_V(krow); } while (0)
#define ST_V(sV, d0, rv) do { \
      *(bf16_t*)((sV) + ((d0) + 0) * 144 + lane * 2) = (bf16_t)((rv).x & 0xffff); *(bf16_t*)((sV) + ((d0) + 1) * 144 + lane * 2) = (bf16_t)((rv).x >> 16); \
      *(bf16_t*)((sV) + ((d0) + 2) * 144 + lane * 2) = (bf16_t)((rv).y & 0xffff); *(bf16_t*)((sV) + ((d0) + 3) * 144 + lane * 2) = (bf16_t)((rv).y >> 16); \
      *(bf16_t*)((sV) + ((d0) + 4) * 144 + lane * 2) = (bf16_t)((rv).z & 0xffff); *(bf16_t*)((sV) + ((d0) + 5) * 144 + lane * 2) = (bf16_t)((rv).z >> 16); \
      *(bf16_t*)((sV) + ((d0) + 6) * 144 + lane * 2) = (bf16_t)((rv).w & 0xffff); *(bf16_t*)((sV) + ((d0) + 7) * 144 + lane * 2) = (bf16_t)((rv).w >> 16); } while (0)
#define STORE_TILE(stage) do { char* sK_ = smem + (stage) * 36864 + hk * 18432; char* sV_ = sK_ + 9216; \
      *(uint4*)(sK_ + (tl >> 3) * 144 + (tl & 7) * 16) = rk0; \
      *(uint4*)(sK_ + (32 + (tl >> 3)) * 144 + (tl & 7) * 16) = rk1; \
      ST_V(sV_, wl * 8, rv0); ST_V(sV_, (wl + 4) * 8, rv1); } while (0)
    int kstart_cur, kstart_nxt = 0;
    {
      size_t kr; TILE_ROW(0, kstart_cur, kr);
      LOAD_TILE(kr);
      STORE_TILE(0);
    }
    __syncthreads();
    for (int t = 0; t < ntl; ++t) {
      const bool more = t + 1 < ntl;
      size_t kr_nxt = 0;
      if (more) { TILE_ROW(t + 1, kstart_nxt, kr_nxt); LOAD_TILE_K(kr_nxt); }
      const char* sK = smem + (t & 1) * 36864 + hk * 18432;
      const char* sV = sK + 9216;
      bf16x8 kf[4][2];
#pragma unroll
      for (int k4 = 0; k4 < 4; ++k4)
#pragma unroll
        for (int ks = 0; ks < 2; ++ks) kf[k4][ks] = *(const bf16x8*)(sK + (k4 * 16 + lr) * 144 + ks * 64 + lq * 16);
      const bool masked = (t >= 4) && ((ilo + t - 4) == 0 || (ilo + t - 4) == 4);
      bf16x8 pf[4][2];
      float alpha[4];
#pragma unroll
      for (int qi = 0; qi < 4; ++qi) {
        f32x4 s[4];
        bf16x8 qf[2];
#pragma unroll
        for (int ks = 0; ks < 2; ++ks) qf[ks] = *(const bf16x8*)(sQ + (qi * 16 + lr) * 144 + ks * 64 + lq * 16);
        __builtin_amdgcn_s_setprio(1);
#pragma unroll
        for (int k4 = 0; k4 < 4; ++k4) {
          s[k4] = (f32x4){0.f, 0.f, 0.f, 0.f};
#pragma unroll
          for (int ks = 0; ks < 2; ++ks) s[k4] = __builtin_amdgcn_mfma_f32_16x16x32_bf16(kf[k4][ks], qf[ks], s[k4], 0, 0, 0);
        }
        __builtin_amdgcn_s_setprio(0);
        if (masked) {
          const int qpos = qpos0 + qi * 16 + lr;
#pragma unroll
          for (int k4 = 0; k4 < 4; ++k4)
#pragma unroll
            for (int jj = 0; jj < 4; ++jj) {
              int kp = kstart_cur + k4 * 16 + lq * 4 + jj;
              int df = qpos - kp; if (df < 0) df = -df;
              if (df > 128) s[k4][jj] = -1e30f;
            }
        }
        float mx = -1e30f;
#pragma unroll
        for (int k4 = 0; k4 < 4; ++k4)
#pragma unroll
          for (int jj = 0; jj < 4; ++jj) mx = fmaxf(mx, s[k4][jj]);
        mx = fmaxf(mx, shflx(mx, 16, lane));
        mx = fmaxf(mx, shflx(mx, 32, lane));
        const float mnew = fmaxf(mrun[qi], mx);
        alpha[qi] = __builtin_amdgcn_exp2f((mrun[qi] - mnew) * SC);
        mrun[qi] = mnew;
        const float msc = mnew * SC;
        float ls = 0.f;
#pragma unroll
        for (int k4 = 0; k4 < 4; ++k4)
#pragma unroll
          for (int jj = 0; jj < 4; ++jj) {
            float pv = __builtin_amdgcn_exp2f(__builtin_fmaf(s[k4][jj], SC, -msc));
            s[k4][jj] = pv;
            ls += pv;
          }
        lrun[qi] = lrun[qi] * alpha[qi] + ls;
#pragma unroll
        for (int dt = 0; dt < 4; ++dt) o[qi][dt] = o[qi][dt] * alpha[qi];
#pragma unroll
        for (int kk = 0; kk < 2; ++kk) {
          uint4 pk = make_uint4(pack2(s[2 * kk][0], s[2 * kk][1]), pack2(s[2 * kk][2], s[2 * kk][3]),
                                pack2(s[2 * kk + 1][0], s[2 * kk + 1][1]), pack2(s[2 * kk + 1][2], s[2 * kk + 1][3]));
          pf[qi][kk] = *(bf16x8*)&pk;
        }
      }
      if (more) LOAD_TILE_V(kr_nxt);
#pragma unroll
      for (int dt = 0; dt < 4; ++dt) {
        bf16x8 vf[2];
#pragma unroll
        for (int kk = 0; kk < 2; ++kk) {
          uint2 lo = *(const uint2*)(sV + (dt * 16 + lr) * 144 + ((2 * kk) * 16 + lq * 4) * 2);
          uint2 hi = *(const uint2*)(sV + (dt * 16 + lr) * 144 + ((2 * kk + 1) * 16 + lq * 4) * 2);
          uint4 cmb = make_uint4(lo.x, lo.y, hi.x, hi.y);
          vf[kk] = *(bf16x8*)&cmb;
        }
        __builtin_amdgcn_s_setprio(1);
#pragma unroll
        for (int qi = 0; qi < 4; ++qi) {
#pragma unroll
          for (int kk = 0; kk < 2; ++kk) o[qi][dt] = __builtin_amdgcn_mfma_f32_16x16x32_bf16(vf[kk], pf[qi][kk], o[qi][dt], 0, 0, 0);
        }
        __builtin_amdgcn_s_setprio(0);
      }
      if (more) STORE_TILE((t + 1) & 1);
      kstart_cur = kstart_nxt;
      __syncthreads();
    }
    const float sink2 = p.attn_sink[j2 * 8 + h] * 1.4426950408889634f;
#pragma unroll
    for (int qi = 0; qi < 4; ++qi) {
      float lt = lrun[qi];
      lt += shflx(lt, 16, lane);
      lt += shflx(lt, 32, lane);
      const float inv = __builtin_amdgcn_rcpf(lt + __builtin_amdgcn_exp2f(sink2 - mrun[qi] * SC));
      const size_t row = qrow0 + qi * 16 + lr;
#pragma unroll
      for (int dt = 0; dt < 4; ++dt) {
        const int col = h * 64 + dt * 16 + lq * 4;
        uint2 gg = *(const uint2*)(proj + row * LDP + 768 + col);
        float r0 = o[qi][dt][0] * inv * siluf_(bf2f((bf16_t)(gg.x & 0xffff)));
        float r1 = o[qi][dt][1] * inv * siluf_(bf2f((bf16_t)(gg.x >> 16)));
        float r2 = o[qi][dt][2] * inv * siluf_(bf2f((bf16_t)(gg.y & 0xffff)));
        float r3 = o[qi][dt][3] * inv * siluf_(bf2f((bf16_t)(gg.y >> 16)));
        uint2 u; u.x = pack2(r0, r1); u.y = pack2(r2, r3);
        *(uint2*)(p.abuf + row * DM + col) = u;
      }
    }
  }
}

__device__ __forceinline__ void scan_phase(const P& p, int j2, const int wv_) {
  int tid_ = (wv_ * 64 + lane_id_opaque()); asm volatile("" : "+v"(tid_));
  const int lane = tid_ & 63, w = tid_ >> 6;
  for (int task = w * gridDim.x + blockIdx.x; task < 1024; task += gridDim.x * NWAVES) {
    const int dir = task & 1, b = (task >> 1) & 15, g = task >> 5;
    const float* aTp = p.aT + ((size_t)(j2 * 32 + g) * 2 + dir) * 128 + lane * 2;
    const float ar = aTp[0], ai = aTp[1];
    const bf16_t* S = (const bf16_t*)p.Sbuf + ((size_t)g * 4352 + b * 272) * 256 + dir * 128 + lane;
    bf16_t* H = p.XH + ((size_t)g * 4352 + b * 272) * 512 + 256 + dir * 128 + lane;
    float hr = 0.f, hi = 0.f;
    float sr[16], si[16], nr[16], ni[16];
#pragma unroll
    for (int s = 0; s < 16; ++s) {
      int q = s;
      int kap = dir == 0 ? q : (q < 16 ? 15 - q : 287 - q);
      sr[s] = bf2f(S[(size_t)kap * 256]);
      si[s] = bf2f(S[(size_t)kap * 256 + 64]);
    }
    for (int bt = 0; bt < 17; ++bt) {
      if (bt + 1 < 17) {
#pragma unroll
        for (int s = 0; s < 16; ++s) {
          int q = (bt + 1) * 16 + s;
          int kap = dir == 0 ? q : (q < 16 ? 15 - q : 287 - q);
          nr[s] = bf2f(S[(size_t)kap * 256]);
          ni[s] = bf2f(S[(size_t)kap * 256 + 64]);
        }
      }
#pragma unroll
      for (int s = 0; s < 16; ++s) {
        int q = bt * 16 + s;
        int kap = dir == 0 ? q : (q < 16 ? 15 - q : 287 - q);
        H[(size_t)kap * 512] = f2bf(hr);
        H[(size_t)kap * 512 + 64] = f2bf(hi);
        float t0 = ar * hr - ai * hi + sr[s];
        float t1 = ar * hi + ai * hr + si[s];
        hr = t0; hi = t1;
      }
#pragma unroll
      for (int s = 0; s < 16; ++s) { sr[s] = nr[s]; si[s] = ni[s]; }
    }
  }
}

__device__ __forceinline__ void acc8(float (&S)[8], const uint4 v, const float sgn) {
  const unsigned vv[4] = {v.x, v.y, v.z, v.w};
#pragma unroll
  for (int e = 0; e < 4; ++e) { S[2 * e] += sgn * bf2f((bf16_t)(vv[e] & 0xffff)); S[2 * e + 1] += sgn * bf2f((bf16_t)(vv[e] >> 16)); }
}
template <int R>
__device__ __forceinline__ void pool_run(const P& p, int row0, int cc, int j2) {
  constexpr int NR = 2 * R + 1;
  int base, len;
  if (row0 < NLAT) { base = row0 & ~4095; len = 4096; } else { base = NLAT + ((row0 - NLAT) & ~255); len = 256; }
  const int pos0 = row0 - base;
  const bf16_t* src = p.proj + (size_t)base * LDO + cc * 8;
  uint4 ring[NR];
  float S[8];
#pragma unroll
  for (int e = 0; e < 8; ++e) S[e] = 0.f;
  int cnt = 0;
#pragma unroll
  for (int d = 0; d < NR; ++d) {
    int q = pos0 - R + d;
    const bool ok = (q >= 0) && (q < len);
    q = q < 0 ? 0 : (q >= len ? len - 1 : q);
    uint4 v = *(const uint4*)(src + (size_t)q * LDO);
    if (!ok) v = make_uint4(0u, 0u, 0u, 0u);
    ring[d] = v;
    acc8(S, v, 1.0f);
    cnt += ok ? 1 : 0;
  }
  const float4 ps0 = *(const float4*)(p.pool_scale + j2 * 1024 + cc * 8), ps1 = *(const float4*)(p.pool_scale + j2 * 1024 + cc * 8 + 4);
  const float ps[8] = {ps0.x, ps0.y, ps0.z, ps0.w, ps1.x, ps1.y, ps1.z, ps1.w};
#pragma unroll
  for (int st = 0; st < 16; ++st) {
    const int t = pos0 + st;
    const uint4 cv4 = ring[(st + R) % NR];
    const uint4 gv = *(const uint4*)(src + (size_t)t * LDO + 1024);
    const unsigned cv[4] = {cv4.x, cv4.y, cv4.z, cv4.w}, gg[4] = {gv.x, gv.y, gv.z, gv.w};
    const float inv = 1.0f / (float)cnt;
    unsigned oo[4];
#pragma unroll
    for (int e = 0; e < 4; ++e) {
      float a0 = (S[2 * e] * inv - bf2f((bf16_t)(cv[e] & 0xffff))) * ps[2 * e] * siluf_(bf2f((bf16_t)(gg[e] & 0xffff)));
      float a1 = (S[2 * e + 1] * inv - bf2f((bf16_t)(cv[e] >> 16))) * ps[2 * e + 1] * siluf_(bf2f((bf16_t)(gg[e] >> 16)));
      oo[e] = pack2(a0, a1);
    }
    *(uint4*)(p.bbuf + (size_t)(base + t) * DM + cc * 8) = make_uint4(oo[0], oo[1], oo[2], oo[3]);
    if (st < 15) {
      const int slot = st % NR;
      acc8(S, ring[slot], -1.0f);
      cnt -= (t - R >= 0) ? 1 : 0;
      int qn = t + R + 1;
      const bool okn = qn < len;
      qn = okn ? qn : len - 1;
      uint4 v = *(const uint4*)(src + (size_t)qn * LDO);
      if (!okn) v = make_uint4(0u, 0u, 0u, 0u);
      ring[slot] = v;
      acc8(S, v, 1.0f);
      cnt += okn ? 1 : 0;
    }
  }
}

__device__ __forceinline__ void pool_phase(const P& p, int Mrows, int j2, const int wv_) {
  int tid_ = (wv_ * 64 + lane_id_opaque()); asm volatile("" : "+v"(tid_));
  const int lane = tid_ & 63, w = __builtin_amdgcn_readfirstlane(tid_ >> 6);
  const int nw = Mrows >> 3;
  for (int W = w * gridDim.x + blockIdx.x; W < nw; W += gridDim.x * NWAVES) {
    const int gi = W & 3, row0 = ((W >> 2) * 2 + (lane >> 5)) * 16, cc = gi * 32 + (lane & 31);
    if (gi == 0) pool_run<1>(p, row0, cc, j2);
    else if (gi == 1) pool_run<2>(p, row0, cc, j2);
    else if (gi == 2) pool_run<4>(p, row0, cc, j2);
    else pool_run<8>(p, row0, cc, j2);
  }
}

__device__ __forceinline__ void fast_barrier(unsigned* bar, unsigned& epoch, const int wv_) {
  asm volatile("s_waitcnt vmcnt(0) lgkmcnt(0)" ::: "memory");
  __syncthreads();
  ++epoch;
  if (wv_ == 0 && lane_id_opaque() == 0) {
    __builtin_amdgcn_fence(__ATOMIC_RELEASE, "agent");
    const unsigned g = blockIdx.x & 15u;
    const unsigned ngrp = (gridDim.x + 15u - g) >> 4;
    const unsigned ngroups = gridDim.x < 16u ? gridDim.x : 16u;
    const unsigned old = __hip_atomic_fetch_add(bar + 64 + 64 * g, 1u, __ATOMIC_RELAXED, __HIP_MEMORY_SCOPE_AGENT);
    if (old + 1u == ngrp * epoch) {
      __builtin_amdgcn_fence(__ATOMIC_ACQ_REL, "agent");
      __hip_atomic_fetch_add(bar, 1u, __ATOMIC_RELAXED, __HIP_MEMORY_SCOPE_AGENT);
    }
    while (__hip_atomic_load(bar, __ATOMIC_RELAXED, __HIP_MEMORY_SCOPE_AGENT) < ngroups * epoch) __builtin_amdgcn_s_sleep(1);
    __builtin_amdgcn_fence(__ATOMIC_ACQUIRE, "agent");
  }
  __syncthreads();
}

__global__ void __launch_bounds__(NTHREADS, 2) fwd_megakernel(P p_arg) {
  const P& p = *(const P*)__builtin_amdgcn_kernarg_segment_ptr();
  extern __shared__ __attribute__((aligned(16))) char smem[];
  const int wv_ = __builtin_amdgcn_readfirstlane((int)hipThreadIdx_x >> 6);
  cg::grid_group grid = cg::this_grid();
  const int ph_lo = p.ph_lo, ph_hi = p.ph_hi;
  int ph = 0;
#ifdef MULTI_LAUNCH
#define PHASE(...) do { if (ph >= ph_lo && ph < ph_hi) { __VA_ARGS__; } ++ph; } while (0)
#define LAST_PHASE(...) PHASE(__VA_ARGS__)
#else
#if DUP_PHASE >= 0
#define PHASE(...) do { const int nrep_ = (ph == DUP_PHASE) ? 2 : 1; for (int rep_ = 0; rep_ < nrep_; ++rep_) { __VA_ARGS__; fast_barrier(p.bar, epoch_, wv_); } ++ph; } while (0)
#else
#define PHASE(...) do { __VA_ARGS__; fast_barrier(p.bar, epoch_, wv_); } while (0)
#endif
#define LAST_PHASE(...) do { __VA_ARGS__; } while (0)
#endif
  unsigned epoch_ = 0;
#ifdef MULTI_LAUNCH
  PHASE(setup_phase(p, smem, 0, SETUP_A_END, wv_));
#else
  setup_phase(p, smem, 0, SETUP_A_END, wv_);
  grid.sync();
#endif
  for (int layer = 0; layer < 4; ++layer) {
    const int j2 = layer >> 1;
    const int Mrows = layer == 3 ? NLAT : MALL;
    const int Mout = layer >= 2 ? NLAT : MALL;
    if (layer == 0) {
      PHASE(norm_phase(p, layer, Mrows, wv_);
            setup_phase(p, smem, SETUP_A_END, SETUP_B_END, wv_);
            bias_phase(p, smem, 0, wv_));
    }
    const bf16_t* Ain = layer == 0 ? p.abuf : ((layer & 1) ? p.bbuf : p.abuf);
    if ((layer & 1) == 0) {
      PHASE(run_gemm<EPI_EVEN_IN>(p, smem, Ain, DM, p.WinE + (size_t)j2 * 2304 * 1024, 1024, Mrows, 2304, 1024, 1, layer, wv_));
      PHASE(attn_phase(p, smem, j2, layer >= 2 ? 1024 : 1088, wv_);
            run_gemm<EPI_S5_S>(p, smem, p.XH, 512, p.Wst + (size_t)j2 * 32 * 65536, 256, 4352, 256, 256, 32, layer, wv_));
      PHASE(scan_phase(p, j2, wv_);
            if (layer == 0) setup_phase(p, smem, SETUP_B_END, SETUP_C_END, wv_));
      PHASE(if (layer == 0) run_gemm<EPI_MERGE>(p, smem, p.WuO, 1024, p.Wpool, 256, 1024, 1024, 256, 2, 0, wv_);
            run_gemm<EPI_S5_Y>(p, smem, p.XH, 512, p.W2 + (size_t)j2 * 32 * 131072, 512, 4352, 256, 512, 32, layer, wv_));
      PHASE(if (layer == 0) bias_phase(p, smem, 1, wv_);
            run_gemm<EPI_GLU>(p, smem, p.bbuf, 512, p.Wglu + (size_t)j2 * 512 * 512, 512, Mout, 512, 512, 1, layer, wv_));
    } else {
      PHASE(run_gemm<EPI_BF16>(p, smem, Ain, DM, p.WinO + (size_t)j2 * 2048 * 1024, 1024, Mrows, 2048, 1024, 1, layer, wv_));
      PHASE(pool_phase(p, Mrows, j2, wv_));
    }
    {
      const bool even = (layer & 1) == 0;
      PHASE(run_gemm<EPI_RESID>(p, smem, even ? p.abuf : p.bbuf, DM, (even ? p.WoutE : p.WoutO) + (size_t)j2 * 1024 * 1024, 1024, Mout, 1024, 1024, 1, layer, wv_));
    }
  }
  LAST_PHASE(final_phase(p, wv_));
}
#define N_PHASES 21

extern "C" void kernel_launch(void* const* d_in, const int* in_sizes, int n_in, void* d_out, int out_size, void* d_ws,
                              size_t ws_size, hipStream_t stream) {
  static int grid_blocks = 0;
  if (!grid_blocks) {
    int dev = 0, cus = 0, per_cu = 0;
    hipGetDevice(&dev);
    hipDeviceGetAttribute(&cus, hipDeviceAttributeMultiprocessorCount, dev);
    hipFuncSetAttribute((const void*)fwd_megakernel, hipFuncAttributeMaxDynamicSharedMemorySize, LDS_BYTES);
    hipOccupancyMaxActiveBlocksPerMultiprocessor(&per_cu, (const void*)fwd_megakernel, NTHREADS, LDS_BYTES);
    if (per_cu < 1) per_cu = 1;
    if (per_cu > 1) per_cu = 1;
    grid_blocks = (cus * per_cu) & ~7;
    if (grid_blocks < 8) grid_blocks = 8;
    fprintf(stderr, "kernel_launch: cus=%d per_cu=%d grid=%d ws=%zu\n", cus, per_cu, grid_blocks, ws_size);
  }
  P p{};
  const float* const* in = (const float* const*)d_in;
  p.x = in[0]; p.c = in[1]; p.ctx = in[2]; p.c_ctx = in[3]; p.ada_w = in[4]; p.ada_b = in[5]; p.norm_g = in[6];
  p.even_w_in = in[7]; p.even_w_out = in[8]; p.attn_sink = in[9]; p.a_re = in[10]; p.a_im = in[11]; p.log_dt = in[12];
  p.b_re = in[13]; p.b_im = in[14]; p.c_re = in[15]; p.c_im = in[16]; p.ssm_d = in[17]; p.glu_w = in[18]; p.glu_b = in[19];
  p.odd_w_in = in[20]; p.odd_w_out = in[21]; p.pool_w = in[22]; p.pool_scale = in[23]; p.final_g = in[24];
  p.out = (float*)d_out;
  char* ws = (char*)d_ws;
  size_t off = 0;
  auto take = [&](size_t bytes) { char* r = ws + off; off += (bytes + 255) & ~(size_t)255; return r; };
  p.mod = (float*)take((size_t)4 * 17 * 3072 * 4);
  p.rope = (float*)take(1024 * 2 * 4);
  p.aT = (float*)take((size_t)64 * 2 * 128 * 4);
  p.klag = (float*)take((size_t)64 * 8192 * 4);
  p.WinE = (bf16_t*)take((size_t)2 * 2304 * 1024 * 2);
  p.WoutE = (bf16_t*)take((size_t)2 * 1024 * 1024 * 2);
  p.Wglu = (bf16_t*)take((size_t)2 * 512 * 512 * 2);
  p.WinO = (bf16_t*)take((size_t)2 * 2048 * 1024 * 2);
  p.WoutO = (bf16_t*)take((size_t)2 * 1024 * 1024 * 2);
  p.Wpool = (bf16_t*)take((size_t)2 * 1024 * 256 * 2);
  p.Wst = (bf16_t*)take((size_t)64 * 65536 * 2);
  p.W2 = (bf16_t*)take((size_t)64 * 131072 * 2);
  p.hctx = (float*)take((size_t)4096 * 1024 * 4);
  p.abuf = (bf16_t*)take((size_t)MALL * 1024 * 2);
  p.bbuf = (bf16_t*)take((size_t)MALL * 1024 * 2);
  p.Sbuf = (float*)p.bbuf;
  p.proj = (bf16_t*)take((size_t)MALL * 2304 * 2);
  p.XH = (bf16_t*)take((size_t)32 * 4352 * 512 * 2);
  p.WuO = (bf16_t*)take((size_t)2 * 1024 * 1024 * 2);
  p.bar = (unsigned*)take(4096);
  p.rowss = (float*)take((size_t)4 * MALL * 4);
  p.bias = (float*)take((size_t)4 * 17 * 2304 * 4);
  if (off > ws_size) { fprintf(stderr, "kernel_launch: workspace too small: need %zu have %zu\n", off, ws_size); return; }
#ifdef MULTI_LAUNCH
  for (int k = 0; k < N_PHASES; ++k) {
    p.ph_lo = k; p.ph_hi = k + 1;
    hipLaunchKernelGGL(fwd_megakernel, dim3(grid_blocks), dim3(NTHREADS), LDS_BYTES, stream, p);
  }
#else
  p.ph_lo = 0; p.ph_hi = N_PHASES;
  hipMemsetAsync(p.bar, 0, 4096, stream);
  void* args[] = {&p};
  hipError_t e = hipLaunchCooperativeKernel((const void*)fwd_megakernel, dim3(grid_blocks), dim3(NTHREADS), args, LDS_BYTES, stream);
  if (e != hipSuccess) fprintf(stderr, "cooperative launch failed: %s (grid %d)\n", hipGetErrorString(e), grid_blocks);
#endif
}
```
